# Optimizing an MI355X kernel written in HIP

```python
import math
import jax, jax.numpy as jnp
from jax import lax
import numpy as np

D_MODEL = 1024
BATCH = 16
SEQ = 2048
DEPTH = 1

GRID_W = 64
N_FOURIER_GROUPS = 8
FOURIER_GROUP_DIM = 64
FOURIER_WIDTH = N_FOURIER_GROUPS * FOURIER_GROUP_DIM
N_Q_HEADS = 16
N_KV_HEADS = 4
HEAD_DIM = 64
Q_GROUP = N_Q_HEADS // N_KV_HEADS
ATTN_WIDTH = N_Q_HEADS * HEAD_DIM
KV_WIDTH = N_KV_HEADS * HEAD_DIM
Q_BLOCK = 128
ROPE_THETA = 10000.0
QK_EPS = 1e-6
N_BRANCHES = 2
OFF_Q = FOURIER_WIDTH
OFF_K = OFF_Q + ATTN_WIDTH
OFF_V = OFF_K + KV_WIDTH
OFF_G = OFF_V + KV_WIDTH
IN_WIDTH = OFF_G + N_BRANCHES * D_MODEL
N_EXPERTS = 256
TOP_K = 8
N_EXPERT_GROUPS = 8
TOPK_GROUPS = 4
EXPERT_DIM = 256
SHARED_DIM = 256
ROUTED_SCALE = 2.5
DISPATCH_BLOCK = 128
LN_EPS = 1e-5
DEEPNORM_ALPHA = (2 * DEPTH) ** 0.25
DEEPNORM_BETA = (8 * DEPTH) ** -0.25

kernel_name = "hybrid_fourier_axial_gqa_moe_deepnorm"


def layer_norm(x, g, b):
    xf = x.astype(jnp.float32)
    mu = jnp.mean(xf, axis=-1, keepdims=True)
    var = jnp.mean(jnp.square(xf - mu), axis=-1, keepdims=True)
    y = (xf - mu) * lax.rsqrt(var + LN_EPS)
    return (y * g.astype(jnp.float32) + b.astype(jnp.float32)).astype(x.dtype)


def rms_norm(x, g):
    xf = x.astype(jnp.float32)
    y = xf * lax.rsqrt(jnp.mean(jnp.square(xf), axis=-1, keepdims=True) + QK_EPS)
    return (y * g.astype(jnp.float32)).astype(x.dtype)


def rope_1d(x, pos):
    half = x.shape[-1] // 2
    freqs = ROPE_THETA ** (-jnp.arange(half, dtype=jnp.float32) / half)
    ang = pos.astype(jnp.float32)[:, None] * freqs
    cos = jnp.cos(ang)[:, None, :].astype(x.dtype)
    sin = jnp.sin(ang)[:, None, :].astype(x.dtype)
    x1, x2 = x[..., :half], x[..., half:]
    return jnp.concatenate([x1 * cos - x2 * sin, x2 * cos + x1 * sin], axis=-1)


def rope_axial(x, row, col):
    h = x.shape[-1] // 2
    return jnp.concatenate([rope_1d(x[..., :h], row), rope_1d(x[..., h:], col)], axis=-1)


def fourier_branch(u):
    B, S, _ = u.shape
    ug = u.reshape(B, S, N_FOURIER_GROUPS, FOURIER_GROUP_DIM).astype(jnp.float32)
    f = jnp.fft.fftn(ug, axes=(1, 3), norm="ortho").real
    return f.reshape(B, S, FOURIER_WIDTH).astype(u.dtype)


def attention_branch(q, k, v, q_g, k_g, row, col):
    B, S, _ = q.shape
    q = rope_axial(rms_norm(q.reshape(B, S, N_Q_HEADS, HEAD_DIM), q_g), row, col)
    k = rope_axial(rms_norm(k.reshape(B, S, N_KV_HEADS, HEAD_DIM), k_g), row, col)
    v = v.reshape(B, S, N_KV_HEADS, HEAD_DIM)
    n_blk = S // Q_BLOCK
    qb = q.reshape(B, n_blk, Q_BLOCK, N_KV_HEADS, Q_GROUP, HEAD_DIM).transpose(1, 0, 2, 3, 4, 5)
    scale = HEAD_DIM ** -0.5

    def attend(q_blk):
        s = jnp.einsum("bqhgd,bkhd->bhgqk", q_blk, k, preferred_element_type=jnp.float32) * scale
        p = jax.nn.softmax(s, axis=-1)
        return jnp.einsum("bhgqk,bkhd->bqhgd", p.astype(v.dtype), v)

    o = lax.map(attend, qb)
    return o.transpose(1, 0, 2, 3, 4, 5).reshape(B, S, ATTN_WIDTH)


def hybrid_mixer(x, w_in, b_gate, q_norm_g, k_norm_g, w_four_proj, w_attn_proj, w_o):
    B, S, _ = x.shape
    rows = S // GRID_W
    row = jnp.repeat(jnp.arange(rows, dtype=jnp.int32), GRID_W)
    col = jnp.tile(jnp.arange(GRID_W, dtype=jnp.int32), rows)
    z = x @ w_in
    y_four = fourier_branch(z[..., :OFF_Q]) @ w_four_proj
    y_attn = attention_branch(z[..., OFF_Q:OFF_K], z[..., OFF_K:OFF_V], z[..., OFF_V:OFF_G],
                              q_norm_g, k_norm_g, row, col) @ w_attn_proj
    gates = jax.nn.sigmoid(z[..., OFF_G:] + b_gate)
    merged = gates[..., :D_MODEL] * y_four + gates[..., D_MODEL:] * y_attn
    return merged @ w_o


def swiglu(x, w_in, w_down):
    g, u = jnp.split(x @ w_in, 2, axis=-1)
    return (jax.nn.silu(g) * u) @ w_down


def route(xt, w_router, e_bias):
    N = xt.shape[0]
    scores = jax.nn.sigmoid(jnp.dot(xt, w_router, preferred_element_type=jnp.float32))
    biased = scores + e_bias.astype(jnp.float32)
    grp = biased.reshape(N, N_EXPERT_GROUPS, N_EXPERTS // N_EXPERT_GROUPS)
    grp_score = lax.top_k(grp, 2)[0].sum(-1)
    _, gidx = lax.top_k(grp_score, TOPK_GROUPS)
    gmask = jax.nn.one_hot(gidx, N_EXPERT_GROUPS, dtype=jnp.float32).sum(-2) > 0
    emask = jnp.repeat(gmask, N_EXPERTS // N_EXPERT_GROUPS, axis=-1)
    _, eidx = lax.top_k(jnp.where(emask, biased, -jnp.inf), TOP_K)
    w = jnp.take_along_axis(scores, eidx, axis=-1)
    w = w / jnp.sum(w, axis=-1, keepdims=True) * ROUTED_SCALE
    return eidx.astype(jnp.int32), w


def routed_experts(xt, eidx, ew, w_e_in, w_e_down):
    N, D = xt.shape
    A = N * TOP_K
    flat_e = eidx.reshape(-1)
    flat_tok = jnp.arange(A, dtype=jnp.int32) // TOP_K
    flat_w = ew.reshape(-1).astype(xt.dtype)
    order = jnp.argsort(flat_e)
    se = flat_e[order]
    counts = jnp.bincount(flat_e, length=N_EXPERTS)
    padded = (counts + DISPATCH_BLOCK - 1) // DISPATCH_BLOCK * DISPATCH_BLOCK
    pad_end = jnp.cumsum(padded)
    pad_start = pad_end - padded
    start = jnp.cumsum(counts) - counts
    dest = pad_start[se] + jnp.arange(A, dtype=jnp.int32) - start[se]
    n_blocks = (A + N_EXPERTS * (DISPATCH_BLOCK - 1) + DISPATCH_BLOCK - 1) // DISPATCH_BLOCK
    P = n_blocks * DISPATCH_BLOCK
    row_tok = jnp.full((P,), N, dtype=jnp.int32).at[dest].set(flat_tok[order])
    row_w = jnp.zeros((P,), xt.dtype).at[dest].set(flat_w[order])
    blk_start = jnp.arange(n_blocks, dtype=jnp.int32) * DISPATCH_BLOCK
    blk_e = jnp.minimum(jnp.searchsorted(pad_end, blk_start, side="right"), N_EXPERTS - 1)
    x_pad = jnp.concatenate([xt, jnp.zeros((1, D), xt.dtype)], axis=0)

    def run_block(args):
        tok, wb, e = args
        return swiglu(x_pad[tok], w_e_in[e], w_e_down[e]) * wb[:, None]

    out = lax.map(run_block, (row_tok.reshape(n_blocks, DISPATCH_BLOCK),
                              row_w.reshape(n_blocks, DISPATCH_BLOCK), blk_e))
    y = jnp.zeros((N + 1, D), xt.dtype).at[row_tok].add(out.reshape(P, D))
    return y[:N]


def moe_ffn(x, w_router, e_bias, w_e_in, w_e_down, w_sh_in, w_sh_down):
    B, S, D = x.shape
    xt = x.reshape(B * S, D)
    eidx, ew = route(xt, w_router, e_bias)
    y = routed_experts(xt, eidx, ew, w_e_in, w_e_down) + swiglu(xt, w_sh_in, w_sh_down)
    return y.reshape(B, S, D)


def setup_inputs(seed: int = 0) -> dict:
    key = jax.random.key(seed)
    ks = jax.random.split(key, 20)
    L, D = DEPTH, D_MODEL
    f32 = jnp.float32

    def nrm(k, shape, scale):
        return jax.random.normal(k, shape, f32) * scale

    return {
        "x": jax.random.normal(ks[0], (BATCH, SEQ, D), f32),
        "w_in": nrm(ks[1], (L, D, IN_WIDTH), D ** -0.5),
        "b_gate": nrm(ks[2], (L, N_BRANCHES * D), 0.02),
        "q_norm_g": 1.0 + nrm(ks[3], (L, HEAD_DIM), 0.02),
        "k_norm_g": 1.0 + nrm(ks[4], (L, HEAD_DIM), 0.02),
        "w_four_proj": nrm(ks[5], (L, FOURIER_WIDTH, D), FOURIER_WIDTH ** -0.5),
        "w_attn_proj": nrm(ks[6], (L, ATTN_WIDTH, D), ATTN_WIDTH ** -0.5),
        "w_o": nrm(ks[7], (L, D, D), DEEPNORM_BETA * D ** -0.5),
        "ln1_g": 1.0 + nrm(ks[8], (L, D), 0.02),
        "ln1_b": nrm(ks[9], (L, D), 0.02),
        "w_router": nrm(ks[10], (L, D, N_EXPERTS), D ** -0.5),
        "e_bias": nrm(ks[11], (L, N_EXPERTS), 0.01),
        "w_e_in": nrm(ks[12], (L, N_EXPERTS, D, 2 * EXPERT_DIM), D ** -0.5),
        "w_e_down": nrm(ks[13], (L, N_EXPERTS, EXPERT_DIM, D), DEEPNORM_BETA * EXPERT_DIM ** -0.5),
        "w_sh_in": nrm(ks[14], (L, D, 2 * SHARED_DIM), D ** -0.5),
        "w_sh_down": nrm(ks[15], (L, SHARED_DIM, D), DEEPNORM_BETA * SHARED_DIM ** -0.5),
        "ln2_g": 1.0 + nrm(ks[16], (L, D), 0.02),
        "ln2_b": nrm(ks[17], (L, D), 0.02),
    }


def reference(x, w_in, b_gate, q_norm_g, k_norm_g, w_four_proj, w_attn_proj, w_o,
              ln1_g, ln1_b, w_router, e_bias, w_e_in, w_e_down, w_sh_in, w_sh_down,
              ln2_g, ln2_b):
    for l in range(DEPTH):
        mix = hybrid_mixer(x, w_in[l], b_gate[l], q_norm_g[l], k_norm_g[l],
                           w_four_proj[l], w_attn_proj[l], w_o[l])
        x = layer_norm(DEEPNORM_ALPHA * x + mix, ln1_g[l], ln1_b[l])
        ffn = moe_ffn(x, w_router[l], e_bias[l], w_e_in[l], w_e_down[l], w_sh_in[l], w_sh_down[l])
        x = layer_norm(DEEPNORM_ALPHA * x + ffn, ln2_g[l], ln2_b[l])
    return x
```

```cpp
#include <hip/hip_runtime.h>
#include <hip/hip_bf16.h>
#include <cstdio>
#include <cstdint>
#include <cmath>

#define LAS __attribute__((address_space(3)))
#define GAS __attribute__((address_space(1)))
typedef unsigned short bf16_t;
typedef short bf16x8 __attribute__((ext_vector_type(8)));
typedef float f32x4 __attribute__((ext_vector_type(4)));
typedef float f32x2 __attribute__((ext_vector_type(2)));
typedef unsigned u32x4 __attribute__((ext_vector_type(4)));
typedef unsigned u32x2 __attribute__((ext_vector_type(2)));
typedef GAS unsigned gu32;

constexpr int NTOK = 32768, DM = 1024, SEQ = 2048, NBATCH = 16;
constexpr int INW = 4096, OFFQ = 512, OFFK = 1536, OFFV = 1792, OFFG = 2048;
constexpr int NEXP = 256, TOPK = 8;
constexpr int MAXTILES = 1280, PMAX = MAXTILES * 256;
constexpr float ALPHA = 1.18920711500272f;
constexpr float LN_EPS = 1e-5f, QK_EPS = 1e-6f;
constexpr float ATT_C2 = 0.125f * 1.4426950408889634f;

__device__ __forceinline__ unsigned cvt_pk_bf16(float lo, float hi) { unsigned r; asm volatile("v_cvt_pk_bf16_f32 %0, %1, %2" : "=v"(r) : "v"(lo), "v"(hi)); return r; }
__device__ __forceinline__ float bf_lo(unsigned u) { return __uint_as_float(u << 16); }
__device__ __forceinline__ float bf_hi(unsigned u) { return __uint_as_float(u & 0xffff0000u); }
__device__ __forceinline__ float fast_sigmoid(float x) { return __builtin_amdgcn_rcpf(1.0f + __builtin_amdgcn_exp2f(-1.4426950408889634f * x)); }

namespace pg8 {
constexpr int BM = 256, BK = 64, HALF = 128, HTB = HALF * BK * 2, STAGE_BYTES = 8 * HTB;
__host__ __device__ __forceinline__ int lds_byte(int r, int c) { const int st = (r >> 4) * 2 + (c >> 5), rr = r & 15, cc = c & 31, ob = rr * 64 + cc * 2; return st * 1024 + (ob ^ (((ob >> 9) & 1) << 5)); }
__host__ __device__ __forceinline__ void stage_rc(int b, int& R, int& C) { const int st = b / 1024, sb = b % 1024, swz = sb ^ (((sb >> 9) & 1) << 5); R = (st >> 1) * 16 + swz / 64; C = (st & 1) * 32 + (swz % 64) / 2; }
__host__ __device__ __forceinline__ int perm32(int rho) { const int n = rho >> 4, i = rho & 15; return 8 * (i >> 2) + 4 * n + (i & 3); }
__host__ __device__ __forceinline__ int invperm32(int s) { return 16 * ((s >> 2) & 1) + 4 * (s >> 3) + (s & 3); }

struct GUnit {
    const char* A; const char* B; char* out;
    const int* gather;
    unsigned lda, ldb;
    int K, pm, pn, kind, aux, flags;
};
__device__ __forceinline__ int xcd_remap(int L, int n) { const int q = n >> 3, r = n & 7, x = L & 7, off = L >> 3; return (x < r ? x * (q + 1) : r * (q + 1) + (x - r) * q) + off; }
__device__ __forceinline__ void tile_order(int L, int nM, int nN, int& pm, int& pn) {
    const int nwg = nM * nN; const int wgid = xcd_remap(L, nwg);
    const int nig = 8 * nN, gid = wgid / nig, fm = gid * 8, gsz = (nM - fm) < 8 ? (nM - fm) : 8;
    pm = fm + ((wgid % nig) % gsz); pn = (wgid % nig) / gsz;
}

template <bool GATHER>
__device__ __forceinline__ void unit_voff(const GUnit& u, int tid, unsigned (&vA)[2][2], unsigned (&vB)[2], const int (&gi)[2][2]) {
#pragma unroll
    for (int i = 0; i < 2; ++i) { int R, C; stage_rc(tid * 16 + i * 8192, R, C);
        const int Rb = (u.flags & 2) ? ((R & ~31) + perm32(R & 31)) : R;
        vB[i] = (unsigned)Rb * u.ldb + (unsigned)C * 2u;
#pragma unroll
        for (int h = 0; h < 2; ++h) { const unsigned row = GATHER ? (unsigned)gi[h][i] : (unsigned)(h * HALF + R); vA[h][i] = row * u.lda + (unsigned)C * 2u; } }
}
template <bool GATHER>
__device__ __forceinline__ void unit_gi(const GUnit& u, int tid, int (&gi)[2][2]) {
    if constexpr (GATHER) {
#pragma unroll
        for (int i = 0; i < 2; ++i) { int R, C; stage_rc(tid * 16 + i * 8192, R, C);
#pragma unroll
            for (int h = 0; h < 2; ++h) gi[h][i] = u.gather[h * HALF + R]; } }
}

template <class Epi, class Sched>
__device__ __forceinline__ void gemm_phase(LAS unsigned char* lds, const Sched& S, const Epi& E) {
    constexpr bool GATHER = Sched::GATHER;
    int tid_ = threadIdx.x; asm volatile("" : "+v"(tid_));
    const int tid = tid_, wid = __builtin_amdgcn_readfirstlane(tid >> 6), lane = tid & 63, wr = wid >> 2, wc = wid & 3, fr = lane & 15, fq = lane >> 4;
    const unsigned ldsw = (unsigned)wid * 1024u;
    const int aoff = lds_byte(wr * 64 + fr, fq * 8), boff = lds_byte(wc * 32 + fr, fq * 8);
#define PG8_SA(b, h) (((b) * 2 + (h)) * HTB)
#define PG8_SB(b, h) ((4 + (b) * 2 + (h)) * HTB)
#define PG8_ST2(bufoff, gbase, v0, v1) do { \
        __builtin_amdgcn_global_load_lds((const unsigned*)((const char*)(gbase) + (v0)), (LAS unsigned*)(lds + (bufoff) + ldsw), 16, 0, 0); \
        __builtin_amdgcn_global_load_lds((const unsigned*)((const char*)(gbase) + (v1)), (LAS unsigned*)(lds + (bufoff) + ldsw + 8192), 16, 0, 0); } while (0)
#define PG8_STA(bufoff, gbase, h) PG8_ST2(bufoff, gbase, vA[h][0], vA[h][1])
#define PG8_STB(bufoff, gbase) PG8_ST2(bufoff, gbase, vB[0], vB[1])
#define PG8_LDA(dst, b, h) do { _Pragma("unroll") for (int m = 0; m < 4; ++m) _Pragma("unroll") for (int k = 0; k < 2; ++k) dst[m][k] = *(const LAS bf16x8*)(lds + PG8_SA(b, h) + aoff + m * 2048 + k * 1024); } while (0)
#define PG8_LDB(dst, b, h) do { _Pragma("unroll") for (int n = 0; n < 2; ++n) _Pragma("unroll") for (int k = 0; k < 2; ++k) dst[n][k] = *(const LAS bf16x8*)(lds + PG8_SB(b, h) + boff + n * 2048 + k * 1024); } while (0)
#define PG8_MMA(ai, bj, At, Bt) do { __builtin_amdgcn_s_setprio(1); _Pragma("unroll") for (int m = 0; m < 4; ++m) _Pragma("unroll") for (int n = 0; n < 2; ++n) _Pragma("unroll") for (int k = 0; k < 2; ++k) \
        acc[ai][bj][m][n] = __builtin_amdgcn_mfma_f32_16x16x32_bf16(Bt[n][k], At[m][k], acc[ai][bj][m][n], 0, 0, 0); __builtin_amdgcn_s_setprio(0); } while (0)
#define PG8_WAIT_V(n) asm volatile("s_waitcnt vmcnt(" #n ")" ::: "memory")
#define PG8_WAIT_L(n) asm volatile("s_waitcnt lgkmcnt(" #n ")" ::: "memory")
#define PG8_BAR __builtin_amdgcn_s_barrier()
#define PG8_SCHED __builtin_amdgcn_sched_barrier(0)
#define PG8_ZERO() do { _Pragma("unroll") for (int a = 0; a < 2; ++a) _Pragma("unroll") for (int b = 0; b < 2; ++b) _Pragma("unroll") for (int m = 0; m < 4; ++m) _Pragma("unroll") for (int n = 0; n < 2; ++n) acc[a][b][m][n] = (f32x4){0.f, 0.f, 0.f, 0.f}; } while (0)
    GUnit cur, nxt; int ui = 0;
    if (!S.next(0, cur)) return;
    f32x4 acc[2][2][4][2];
    PG8_ZERO();
    bf16x8 At[4][2], B0[2][2], B1[2][2];
    unsigned vA[2][2], vB[2]; int gi[2][2] = {{0, 0}, {0, 0}};
    unit_gi<GATHER>(cur, tid, gi);
    unit_voff<GATHER>(cur, tid, vA, vB, gi);
    size_t hB = (size_t)HALF * cur.ldb;
    const char* cA = cur.A; const char* cB = cur.B;
    constexpr size_t kstep = (size_t)(BK * 2);
    PG8_STB(PG8_SB(0, 0), cB); PG8_STB(PG8_SB(0, 1), cB + hB); PG8_STA(PG8_SA(0, 0), cA, 0); PG8_STA(PG8_SA(0, 1), cA, 1);
    if (wr == 1) PG8_BAR;
    PG8_WAIT_V(2); PG8_BAR;
    PG8_STB(PG8_SB(1, 0), cB + kstep); PG8_STA(PG8_SA(1, 0), cA + kstep, 0); PG8_STB(PG8_SB(1, 1), cB + hB + kstep);
    PG8_WAIT_V(6); PG8_BAR;
    for (;;) {
        const bool has_next = S.next(ui + 1, nxt);
        if (has_next) unit_gi<GATHER>(nxt, tid, gi);
        const char* nA = has_next ? nxt.A : cA; const char* nB = has_next ? nxt.B : cB;
        const int nt = cur.K / BK;
        for (int t = 0; t < nt; t += 2) {
            const bool last = (t == nt - 2);
            const char* a1 = cA + (size_t)(t + 1) * kstep;
            const char* a2 = last ? nA : cA + (size_t)(t + 2) * kstep; const char* b2 = last ? nB : cB + (size_t)(t + 2) * kstep;
            const char* a3 = a2 + kstep; const char* b3 = b2 + kstep;
            PG8_LDB(B0, 0, 0); PG8_LDB(B1, 0, 1); PG8_SCHED; PG8_LDA(At, 0, 0); PG8_STA(PG8_SA(1, 1), a1, 1);
            if (last && has_next) { unit_voff<GATHER>(nxt, tid, vA, vB, gi); hB = (size_t)HALF * nxt.ldb; }
            PG8_WAIT_V(8); PG8_WAIT_L(0); PG8_BAR; PG8_MMA(0, 0, At, B0); PG8_MMA(0, 1, At, B1); PG8_BAR; PG8_SCHED;
            PG8_LDA(At, 0, 1); PG8_STB(PG8_SB(0, 0), b2); PG8_STB(PG8_SB(0, 1), b2 + hB); PG8_STA(PG8_SA(0, 0), a2, 0);
            PG8_WAIT_V(8); PG8_WAIT_L(0); PG8_BAR; PG8_MMA(1, 0, At, B0); PG8_MMA(1, 1, At, B1); PG8_BAR; PG8_SCHED;
            PG8_LDB(B0, 1, 0); PG8_LDB(B1, 1, 1); PG8_SCHED; PG8_LDA(At, 1, 0); PG8_STA(PG8_SA(0, 1), a2, 1);
            PG8_WAIT_V(8); PG8_WAIT_L(0); PG8_BAR; PG8_MMA(0, 0, At, B0); PG8_MMA(0, 1, At, B1); PG8_BAR; PG8_SCHED;
            PG8_LDA(At, 1, 1); PG8_STB(PG8_SB(1, 0), b3); PG8_STB(PG8_SB(1, 1), b3 + hB); PG8_STA(PG8_SA(1, 0), a3, 0);
            PG8_WAIT_V(8); PG8_WAIT_L(0); PG8_BAR; PG8_MMA(1, 0, At, B0); PG8_MMA(1, 1, At, B1); PG8_BAR; PG8_SCHED;
        }
        if (wr == 0) PG8_BAR;
        E(acc, cur, wr, wc, fr, fq);
        if (!has_next) break;
        if (!(nxt.flags & 1)) PG8_ZERO();
        cur = nxt; cA = nA; cB = nB; ++ui;
        if (wr == 1) PG8_BAR;
    }
    PG8_WAIT_V(0);
    PG8_BAR;
#undef PG8_SA
#undef PG8_SB
#undef PG8_ST2
#undef PG8_STA
#undef PG8_STB
#undef PG8_LDA
#undef PG8_LDB
#undef PG8_MMA
#undef PG8_WAIT_V
#undef PG8_WAIT_L
#undef PG8_BAR
#undef PG8_SCHED
#undef PG8_ZERO
}
}

namespace attn_body {
using bf16 = __hip_bfloat16;
using s16x4 = __attribute__((ext_vector_type(4))) short;
using f32x16 = __attribute__((ext_vector_type(16))) float;
constexpr int D = 64, QP = 1024, KP = 256;
constexpr int NW = 8, QBLK = 32, QB = QBLK * NW, KVBLK = 64;
__device__ __forceinline__ int crow(int r, int hi) { return (r & 3) + 8 * (r >> 2) + 4 * hi; }
#define SBAR() __builtin_amdgcn_sched_barrier(0)
constexpr int NSLOT = 3, SLOTB = 8192;
constexpr int LDS_K = 0, LDS_V = NSLOT * SLOTB, LDS_WS = 2 * NSLOT * SLOTB, LDS_OST = LDS_WS + NW * 64 * 4, LDS_BYTES = LDS_OST + NW * 4096;
__device__ __forceinline__ void glds16(const void* gsrc, unsigned lds_dst) { unsigned keep;
  asm volatile("s_mov_b32 %0, m0\n\ts_mov_b32 m0, %2\n\ts_nop 0\n\tglobal_load_lds_dwordx4 %1, off\n\ts_mov_b32 m0, %0" : "=&s"(keep) : "v"(gsrc), "s"(lds_dst) : "memory"); }
__device__ __forceinline__ float max3f(float a, float b, float c) { float r; asm("v_max3_f32 %0, %1, %2, %3" : "=v"(r) : "v"(a), "v"(b), "v"(c)); return r; }
__device__ __forceinline__ float max2f(float a, float b) { float r; asm("v_max_f32_e32 %0, %1, %2" : "=v"(r) : "v"(a), "v"(b)); return r; }
__device__ __forceinline__ float fadd_s(float a, float b) { float r; asm("v_add_f32_e32 %0, %1, %2" : "=v"(r) : "v"(a), "v"(b)); return r; }
__device__ __forceinline__ float fsub_s(float a, float b) { float r; asm("v_sub_f32_e32 %0, %1, %2" : "=v"(r) : "v"(a), "v"(b)); return r; }
typedef float f32x2_t __attribute__((ext_vector_type(2))); typedef __bf16 bf16x2_t __attribute__((ext_vector_type(2)));
__device__ __forceinline__ unsigned cvtpk_s(float lo, float hi) { f32x2_t v = {lo, hi}; bf16x2_t b = __builtin_convertvector(v, bf16x2_t); return __builtin_bit_cast(unsigned, b); }
#define WAIT_BAR(N) asm volatile("s_waitcnt vmcnt(" #N ") lgkmcnt(0)\n\ts_barrier" ::: "memory")
__device__ __forceinline__ void qkt(f32x16& p0, f32x16& p1, const char* Kslot, const bf16x8* qr, const f32x16& negm, int r32, int hi) {
  const char* kb = Kslot + hi * 1024 + r32 * 16;
#pragma unroll
  for (int d0 = 0; d0 < 4; ++d0) {
    const bf16x8 b0 = *reinterpret_cast<const bf16x8*>(kb + d0 * 2048);
    const bf16x8 b1 = *reinterpret_cast<const bf16x8*>(kb + d0 * 2048 + 512);
    if (d0 == 0) { p0 = __builtin_amdgcn_mfma_f32_32x32x16_bf16(b0, qr[0], negm, 0, 0, 0); p1 = __builtin_amdgcn_mfma_f32_32x32x16_bf16(b1, qr[0], negm, 0, 0, 0); }
    else { p0 = __builtin_amdgcn_mfma_f32_32x32x16_bf16(b0, qr[d0], p0, 0, 0, 0); p1 = __builtin_amdgcn_mfma_f32_32x32x16_bf16(b1, qr[d0], p1, 0, 0, 0); } }
}
typedef __attribute__((address_space(3))) const char* lds_cptr;
typedef short v4i16_t __attribute__((ext_vector_type(4)));
__device__ __forceinline__ void kload8(bf16x8* kf, lds_cptr kp) {
  kf[0] = *(const __attribute__((address_space(3))) bf16x8*)(kp);        kf[1] = *(const __attribute__((address_space(3))) bf16x8*)(kp + 512);
  kf[2] = *(const __attribute__((address_space(3))) bf16x8*)(kp + 2048); kf[3] = *(const __attribute__((address_space(3))) bf16x8*)(kp + 2560);
  kf[4] = *(const __attribute__((address_space(3))) bf16x8*)(kp + 4096); kf[5] = *(const __attribute__((address_space(3))) bf16x8*)(kp + 4608);
  kf[6] = *(const __attribute__((address_space(3))) bf16x8*)(kp + 6144); kf[7] = *(const __attribute__((address_space(3))) bf16x8*)(kp + 6656);
}
__device__ __forceinline__ void kload2(bf16x8* kf, lds_cptr kp, int j) { kf[2 * j] = *(const __attribute__((address_space(3))) bf16x8*)(kp + j * 2048); kf[2 * j + 1] = *(const __attribute__((address_space(3))) bf16x8*)(kp + j * 2048 + 512); }
__device__ __forceinline__ s16x4 vtr(lds_cptr p) { return __builtin_bit_cast(s16x4, __builtin_amdgcn_ds_read_tr16_b64_v4i16((__attribute__((address_space(3))) v4i16_t*)p)); }
__device__ __forceinline__ float rowmax(const f32x16& p0, const f32x16& p1) {
  float a = max3f(p0[0], p0[1], p1[0]), b = max3f(p0[2], p0[3], p1[1]); a = max3f(a, p1[2], p1[3]);
#pragma unroll
  for (int r = 4; r < 16; r += 4) { a = max3f(a, p0[r], p0[r + 1]); b = max3f(b, p0[r + 2], p0[r + 3]); a = max3f(a, p1[r], p1[r + 1]); b = max3f(b, p1[r + 2], p1[r + 3]); }
  const float m = max2f(a, b);
  auto rr = __builtin_amdgcn_permlane32_swap(__float_as_uint(m), __float_as_uint(m), false, false);
  return max2f(__uint_as_float(rr[0]), __uint_as_float(rr[1]));
}
__device__ __forceinline__ void pv(f32x16* o, int vb, bf16x8 pa0, bf16x8 pa1, bf16x8 pa2, bf16x8 pa3) {
#pragma unroll
  for (int d0 = 0; d0 < 2; ++d0) { s16x4 lo[4], hi[4];
#pragma unroll
    for (int ks = 0; ks < 4; ++ks) {
      asm volatile("ds_read_b64_tr_b16 %0,%1 offset:%c2" : "=&v"(lo[ks]) : "v"(vb), "i"(d0 * 4096 + ks * 1024) : "memory");
      asm volatile("ds_read_b64_tr_b16 %0,%1 offset:%c2" : "=&v"(hi[ks]) : "v"(vb), "i"(d0 * 4096 + ks * 1024 + 512) : "memory"); }
    asm volatile("s_waitcnt lgkmcnt(0)" ::: "memory"); SBAR();
#define PK(k) (bf16x8){lo[k][0], lo[k][1], lo[k][2], lo[k][3], hi[k][0], hi[k][1], hi[k][2], hi[k][3]}
    o[d0] = __builtin_amdgcn_mfma_f32_32x32x16_bf16(pa0, PK(0), o[d0], 0, 0, 0);
    o[d0] = __builtin_amdgcn_mfma_f32_32x32x16_bf16(pa1, PK(1), o[d0], 0, 0, 0);
    o[d0] = __builtin_amdgcn_mfma_f32_32x32x16_bf16(pa2, PK(2), o[d0], 0, 0, 0);
    o[d0] = __builtin_amdgcn_mfma_f32_32x32x16_bf16(pa3, PK(3), o[d0], 0, 0, 0);
#undef PK
  }
}
#define ATTN_STORE16(p, v) (*(u32x4*)(p) = (v))
template <int THRL> __device__ __forceinline__ void attn_unit(int b, int h, int qb, const bf16* Q, const bf16* __restrict__ K, const bf16* __restrict__ V, bf16* O, char* shm) {
  const int tid = threadIdx.x, lane = tid & 63, r32 = lane & 31, hi = lane >> 5; const int wid = __builtin_amdgcn_readfirstlane(tid >> 6);
  const long rowbase = (long)b * SEQ; const int q0 = qb * QB; const int kvh = h >> 2;
  const bf16* Qw = Q + (rowbase + q0 + wid * QBLK) * QP + h * D;
  const bf16* Kh = K + rowbase * KP + kvh * D, *Vh = V + rowbase * KP + kvh * D;
  const unsigned lds0 = (unsigned)(uintptr_t)shm;
  float* wsf = (float*)(shm + LDS_WS) + wid * 64;
  const bf16* ksrc = Kh + (long)lane * KP + wid * 8;
  const bf16* vsrc = Vh + (long)(16 * (wid & 3) + (lane >> 2)) * KP + (wid >> 2) * 32 + (lane & 3) * 8;
  const unsigned kdst = lds0 + LDS_K + wid * 1024, vdst = lds0 + LDS_V + wid * 1024;
#define DMA_K(t, slot) glds16(ksrc + (long)(t) * KVBLK * KP, (unsigned)__builtin_amdgcn_readfirstlane(kdst + (slot)))
#define DMA_V(t, slot) glds16(vsrc + (long)(t) * KVBLK * KP, (unsigned)__builtin_amdgcn_readfirstlane(vdst + (slot)))
  const int vb0 = (int)(lds0 + LDS_V) + ((lane >> 4) & 1) * 32 + (lane & 3) * 8 + (4 * hi + ((lane & 15) >> 2)) * 64;
  const char* Kbase = shm + LDS_K; bf16x8 kf[8];
  const lds_cptr shm3 = (lds_cptr)shm; const lds_cptr kp0 = shm3 + LDS_K + hi * 1024 + r32 * 16; const lds_cptr vp0 = shm3 + LDS_V + ((lane >> 4) & 1) * 32 + (lane & 3) * 8 + (4 * hi + ((lane & 15) >> 2)) * 64;
  constexpr int NT = SEQ / KVBLK;
  DMA_K(0, 0); DMA_V(0, 0); DMA_K(1, SLOTB);
  bf16x8 qr[4];
#pragma unroll
  for (int d0 = 0; d0 < 4; ++d0) qr[d0] = *reinterpret_cast<const bf16x8*>(&Qw[(long)r32 * QP + d0 * 16 + hi * 8]);
  float mhat = 0.f, l_reg = 0.f; f32x16 o[2]; o[0] = f32x16{}; o[1] = f32x16{}; f32x16 negm = f32x16{}; asm volatile("" : "+v"(negm));
  bool resc = false;
#define START(P0, P1) do { const float rm = rowmax(P0, P1); resc = false; \
    { const float dl = rm; mhat = fadd_s(mhat, dl); \
      _Pragma("unroll") for (int r = 0; r < 16; ++r) { P0[r] = fsub_s(P0[r], dl); P1[r] = fsub_s(P1[r], dl); } \
      _Pragma("unroll") for (int r = 0; r < 16; ++r) negm[r] = -mhat; asm volatile("" : "+v"(negm)); } \
    _Pragma("unroll") for (int r = 0; r < 16; ++r) P0[r] = __builtin_amdgcn_exp2f(P0[r]); } while (0)
#define RESC() do { if (resc) { asm volatile("s_waitcnt lgkmcnt(0)" ::: "memory"); \
      _Pragma("unroll") for (int d_ = 0; d_ < 2; ++d_) _Pragma("unroll") for (int r = 0; r < 16; ++r) o[d_][r] *= wsf[crow(r, hi)]; } } while (0)
  f32x16 pA0, pA1, pB0, pB1;
  int sl_prev = 0, sl_cur = 0, sl_next = SLOTB;
#define ROT() do { sl_prev = sl_cur; sl_cur = sl_next; sl_next = (sl_next == (NSLOT - 1) * SLOTB) ? 0 : sl_next + SLOTB; } while (0)
  DMA_K(2, 2 * SLOTB);
  WAIT_BAR(3);
  qkt(pA0, pA1, Kbase, qr, negm, r32, hi); asm volatile("s_nop 15\n\ts_nop 7" : "+v"(pA0), "+v"(pA1));
  START(pA0, pA1);
  _Pragma("unroll") for (int r = 0; r < 16; ++r) pA1[r] = __builtin_amdgcn_exp2f(pA1[r]);
  WAIT_BAR(0);
  DMA_K(3, 0); DMA_V(1, SLOTB);
  ROT();
  kload8(kf, kp0 + sl_cur);
  WAIT_BAR(2);
  s16x4 vlo[8], vhi[8]; u32x4 pw0, pw1, pw2, pw3;
#define PKW(P, B) cvtpk_s(P[B], P[B + 1])
#define PAF(k) __builtin_bit_cast(bf16x8, pw##k)
#define VFR(i) (bf16x8){vlo[i][0], vlo[i][1], vlo[i][2], vlo[i][3], vhi[i][0], vhi[i][1], vhi[i][2], vhi[i][3]}
#define PIN(x) asm volatile("" : "+v"(x))
#define MX3(a, b, c) __builtin_fmaxf(__builtin_fmaxf((a), (b)), (c))
#define GAPA(MF, A0, A1, A2, A3, W0, W1, PW) do { MF; sacc += A0; sacc += A1; sacc += A2; sacc += A3; PIN(sacc); W0; W1; PIN(PW); SBAR(); } while (0)
#define EX(v) __builtin_amdgcn_exp2f(v)
#define GAPB(MF, X, B) do { MF; X[B] = EX(X[B]); X[B + 1] = EX(X[B + 1]); X[B + 2] = EX(X[B + 2]); X[B + 3] = EX(X[B + 3]); PIN(X); SBAR(); } while (0)
#define VRD(i) do { vlo[i] = vtr(vp_ + (((i) >> 2) * 4096 + ((i) & 3) * 1024)); vhi[i] = vtr(vp_ + (((i) >> 2) * 4096 + ((i) & 3) * 1024 + 512)); } while (0)
#define KRD(G, j) do { if (G) { kload2(kf, kp0 + sl_next, j); SBAR(); } } while (0)
#define STEP(C0, C1, P0, P1, t, GK, GV, GL) do { SBAR(); \
    const lds_cptr vp_ = vp0 + sl_prev; \
    VRD(0); SBAR(); float sacc = (P0[0] + P0[1]); \
    GAPA(C0 = __builtin_amdgcn_mfma_f32_32x32x16_bf16(kf[0], qr[0], negm, 0, 0, 0), P0[2], P0[3], P0[4], P0[5],     pw0[0] = PKW(P0, 0), pw0[1] = PKW(P0, 2), pw0); \
    VRD(4); SBAR(); GAPA(C1 = __builtin_amdgcn_mfma_f32_32x32x16_bf16(kf[1], qr[0], negm, 0, 0, 0), P0[6], P0[7], P0[8], P0[9],     pw0[2] = PKW(P0, 4), pw0[3] = PKW(P0, 6), pw0); \
    VRD(1); SBAR(); GAPA(C0 = __builtin_amdgcn_mfma_f32_32x32x16_bf16(kf[2], qr[1], C0, 0, 0, 0),   P0[10], P0[11], P0[12], P0[13], pw1[0] = PKW(P0, 8), pw1[1] = PKW(P0, 10), pw1); \
    VRD(5); SBAR(); GAPA(C1 = __builtin_amdgcn_mfma_f32_32x32x16_bf16(kf[3], qr[1], C1, 0, 0, 0),   P0[14], P0[15], P1[0], P1[1],   pw1[2] = PKW(P0, 12), pw1[3] = PKW(P0, 14), pw1); \
    VRD(2); SBAR(); GAPA(C0 = __builtin_amdgcn_mfma_f32_32x32x16_bf16(kf[4], qr[2], C0, 0, 0, 0),   P1[2], P1[3], P1[4], P1[5],     pw2[0] = PKW(P1, 0), pw2[1] = PKW(P1, 2), pw2); \
    VRD(6); SBAR(); GAPA(C1 = __builtin_amdgcn_mfma_f32_32x32x16_bf16(kf[5], qr[2], C1, 0, 0, 0),   P1[6], P1[7], P1[8], P1[9],     pw2[2] = PKW(P1, 4), pw2[3] = PKW(P1, 6), pw2); \
    VRD(3); SBAR(); GAPA(C0 = __builtin_amdgcn_mfma_f32_32x32x16_bf16(kf[6], qr[3], C0, 0, 0, 0),   P1[10], P1[11], P1[12], P1[13], pw3[0] = PKW(P1, 8), pw3[1] = PKW(P1, 10), pw3); \
    VRD(7); SBAR(); GAPA(C1 = __builtin_amdgcn_mfma_f32_32x32x16_bf16(kf[7], qr[3], C1, 0, 0, 0),   P1[14], P1[15], 0.f, 0.f,       pw3[2] = PKW(P1, 12), pw3[3] = PKW(P1, 14), pw3); \
    l_reg += sacc; \
    if (GK) { DMA_K((t) + 3, sl_cur); } if (GV) { DMA_V((t) + 1, sl_next); } \
    { float a = MX3(C0[0], C0[1], C1[0]), b = MX3(C0[2], C0[3], C1[1]); a = MX3(a, C1[2], C1[3]); \
      _Pragma("unroll") for (int r = 4; r < 16; r += 4) { a = MX3(a, C0[r], C0[r + 1]); b = MX3(b, C0[r + 2], C0[r + 3]); a = MX3(a, C1[r], C1[r + 1]); b = MX3(b, C1[r + 2], C1[r + 3]); } \
      float rm = __builtin_fmaxf(a, b); { auto rr = __builtin_amdgcn_permlane32_swap(__float_as_uint(rm), __float_as_uint(rm), false, false); rm = __builtin_fmaxf(__uint_as_float(rr[0]), __uint_as_float(rr[1])); } \
      resc = false; \
      if (__builtin_expect(__any(rm > (float)THRL), 0)) { const float dl = __builtin_fmaxf(rm, 0.f); mhat += dl; \
        _Pragma("unroll") for (int r = 0; r < 16; ++r) { C0[r] -= dl; C1[r] -= dl; } \
        _Pragma("unroll") for (int r = 0; r < 16; ++r) negm[r] = -mhat; asm volatile("" : "+v"(negm)); \
        const float f = __builtin_amdgcn_exp2f(-dl); l_reg *= f; if (hi == 0) wsf[r32] = f; resc = true; } } \
    SBAR(); \
    GAPB(o[0] = __builtin_amdgcn_mfma_f32_32x32x16_bf16(PAF(0), VFR(0), o[0], 0, 0, 0), C0, 0); \
    GAPB(o[1] = __builtin_amdgcn_mfma_f32_32x32x16_bf16(PAF(0), VFR(4), o[1], 0, 0, 0), C0, 4); \
    KRD(GL, 0); GAPB(o[0] = __builtin_amdgcn_mfma_f32_32x32x16_bf16(PAF(1), VFR(1), o[0], 0, 0, 0), C0, 8); \
    KRD(GL, 1); GAPB(o[1] = __builtin_amdgcn_mfma_f32_32x32x16_bf16(PAF(1), VFR(5), o[1], 0, 0, 0), C0, 12); \
    KRD(GL, 2); GAPB(o[0] = __builtin_amdgcn_mfma_f32_32x32x16_bf16(PAF(2), VFR(2), o[0], 0, 0, 0), C1, 0); \
    KRD(GL, 3); GAPB(o[1] = __builtin_amdgcn_mfma_f32_32x32x16_bf16(PAF(2), VFR(6), o[1], 0, 0, 0), C1, 4); \
    GAPB(o[0] = __builtin_amdgcn_mfma_f32_32x32x16_bf16(PAF(3), VFR(3), o[0], 0, 0, 0), C1, 8); \
    GAPB(o[1] = __builtin_amdgcn_mfma_f32_32x32x16_bf16(PAF(3), VFR(7), o[1], 0, 0, 0), C1, 12); \
    } while (0)
  int t = 1;
  for (; t + 5 < NT; t += 2) {
    STEP(pB0, pB1, pA0, pA1, t, true, true, true);     WAIT_BAR(2); RESC(); ROT();
    STEP(pA0, pA1, pB0, pB1, t + 1, true, true, true); WAIT_BAR(2); RESC(); ROT();
  }
#define ENDW(tt) do { if ((tt) + 3 < NT) { WAIT_BAR(2); } else if ((tt) + 2 < NT) { WAIT_BAR(1); } else { WAIT_BAR(0); } } while (0)
  for (; t + 1 < NT; t += 2) {
    STEP(pB0, pB1, pA0, pA1, t, (t + 3 < NT), (t + 1 < NT), (t + 1 < NT));         ENDW(t);     RESC(); ROT();
    STEP(pA0, pA1, pB0, pB1, t + 1, (t + 4 < NT), (t + 2 < NT), (t + 2 < NT));     ENDW(t + 1); RESC(); ROT();
  }
  STEP(pB0, pB1, pA0, pA1, NT - 1, false, false, false); RESC();
  { float sacc = pB0[0] + pB0[1]; _Pragma("unroll") for (int r = 2; r < 16; ++r) sacc += pB0[r]; _Pragma("unroll") for (int r = 0; r < 16; ++r) sacc += pB1[r]; l_reg += sacc;
    pw0 = (u32x4){PKW(pB0, 0), PKW(pB0, 2), PKW(pB0, 4), PKW(pB0, 6)}; pw1 = (u32x4){PKW(pB0, 8), PKW(pB0, 10), PKW(pB0, 12), PKW(pB0, 14)}; pw2 = (u32x4){PKW(pB1, 0), PKW(pB1, 2), PKW(pB1, 4), PKW(pB1, 6)}; pw3 = (u32x4){PKW(pB1, 8), PKW(pB1, 10), PKW(pB1, 12), PKW(pB1, 14)};
    SBAR(); pv(o, vb0 + sl_cur, PAF(0), PAF(1), PAF(2), PAF(3)); }
#undef PKW
#undef PAF
#undef VFR
#undef PIN
#undef MX3
#undef GAPA
#undef GAPB
#undef EX
#undef VRD
#undef KRD
#undef STEP
#undef ENDW
  { auto rr = __builtin_amdgcn_permlane32_swap(__float_as_uint(l_reg), __float_as_uint(l_reg), false, false); l_reg = __uint_as_float(rr[0]) + __uint_as_float(rr[1]); }
  if (hi == 0) wsf[32 + r32] = l_reg; asm volatile("s_waitcnt lgkmcnt(0)" ::: "memory");
  float rli[16];
#pragma unroll
  for (int r = 0; r < 16; ++r) rli[r] = __builtin_amdgcn_rcpf(wsf[32 + crow(r, hi)]);
  bf16* Ow = O + (rowbase + q0 + wid * QBLK) * QP + h * D;
  { bf16* stg = (bf16*)(shm + LDS_OST) + wid * 2048;
#pragma unroll
    for (int r = 0; r < 16; ++r) { const int orow = crow(r, hi);
#pragma unroll
      for (int d0 = 0; d0 < 2; ++d0) stg[orow * 64 + d0 * 32 + r32] = __float2bfloat16(o[d0][r] * rli[r]); }
    asm volatile("s_waitcnt lgkmcnt(0)" ::: "memory");
#pragma unroll
    for (int i = 0; i < 4; ++i) { const int row = i * 8 + (lane >> 3), ch = lane & 7; const u32x4 v = *(const u32x4*)(stg + row * 64 + ch * 8); ATTN_STORE16(Ow + (long)row * QP + ch * 8, v); } }
  asm volatile("s_waitcnt lgkmcnt(0)\n\ts_barrier" ::: "memory");
#undef DMA_K
#undef DMA_V
#undef START
#undef RESC
#undef ROT
}
#undef SBAR
#undef WAIT_BAR
}

constexpr size_t MiB = 1u << 20;
constexpr size_t WS_CTL = 0, CTL_ZERO_BYTES = 1 * MiB;
constexpr size_t WS_WQKVG = 2 * MiB, WS_WCS = 10 * MiB, WS_WF = 12 * MiB, WS_WA = 13 * MiB, WS_WO = 15 * MiB, WS_WR = 17 * MiB, WS_WSHIN = 18 * MiB, WS_WSHD = 19 * MiB;
constexpr size_t WS_IOTA = 20 * MiB, WS_ASG_E = 21 * MiB, WS_ASG_POS = 22 * MiB, WS_ASG_W = 23 * MiB, WS_ROW_TOK = 24 * MiB, WS_ROW_SLOT = 26 * MiB, WS_ROW_W = 28 * MiB;
constexpr size_t WS_DFT = 32 * MiB, WS_WEIN = 48 * MiB, WS_WED = 304 * MiB;
constexpr size_t WS_X1 = 432 * MiB, WS_X1B = 560 * MiB, WS_PRE = 624 * MiB, WS_LOGITS = 752 * MiB, WS_H = 784 * MiB, WS_HS = 944 * MiB, WS_YSH = 960 * MiB;
constexpr size_t WS_YBUF = 1024 * MiB;
constexpr size_t WS_XB = 1024 * MiB, WS_UT = 1088 * MiB, WS_Q = 1152 * MiB, WS_K = 1216 * MiB, WS_V = 1232 * MiB, WS_G = 1248 * MiB, WS_F = 1376 * MiB, WS_AO = 1408 * MiB, WS_MERGED = 1472 * MiB;
constexpr size_t WS_END = 1536 * MiB;
constexpr int CW_TMO = 0, CW_CODE = 1, CW_BAR = 4096, CW_CNT = 16384;

constexpr int RING_OFF = 0, RING_BYTES = 131072;
constexpr int ROPE_OFF = 131072;
constexpr int TILE_E_OFF = 139264;
constexpr int EBASE_OFF = 144384;
constexpr int HIST_OFF = 145440, WGOFF_OFF = 146464, ASG_OFF = 147488;
constexpr int MISC_OFF = 151584;
constexpr int LDS_BYTES = 163840;
static_assert(MISC_OFF + 128 <= LDS_BYTES, "LDS map");

#define RLX_AGENT __ATOMIC_RELAXED, __HIP_MEMORY_SCOPE_AGENT
#define LDS_WAIT() asm volatile("s_waitcnt lgkmcnt(0)" ::: "memory")
#define VM_WAIT() asm volatile("s_waitcnt vmcnt(0)" ::: "memory")

#define XB_TMO      128
#define XB_XCNT(j)  (256  + 64 * (j))
#define XB_XSUB(j)  (1280 + 64 * (j))
#define XB_XGEN(j)  (2304 + 64 * (j))
#define XB_TOP      3328
#define XB_TOPGEN   3392
#define XCD_BAR_WORDS 3456
#define XB_SPIN_CAP (1u << 18)
__device__ __forceinline__ unsigned xb_ld(unsigned* p)              { return __hip_atomic_load(p, __ATOMIC_RELAXED, __HIP_MEMORY_SCOPE_AGENT); }
__device__ __forceinline__ unsigned xb_add(unsigned* p, unsigned v) { return __hip_atomic_fetch_add(p, v, __ATOMIC_RELAXED, __HIP_MEMORY_SCOPE_AGENT); }
__device__ __forceinline__ unsigned xb_xcc_id() { return (unsigned)__builtin_amdgcn_s_getreg((3 << 11) | 20) & 0xFu; }
#define XB_SPIN(cond, bar) do { unsigned _sp = 0; while (cond) { __builtin_amdgcn_s_sleep(1); \
    if ((++_sp & 255u) == 0u) { if (xb_ld(&(bar)[XB_TMO])) break; if (_sp > XB_SPIN_CAP) { atomicAdd(&(bar)[XB_TMO], 1u); break; } } } } while (0)
struct XcdBarrier { unsigned* bar; unsigned x; volatile LAS unsigned* st; };
__device__ __forceinline__ XcdBarrier xcd_barrier_post(unsigned* bar, volatile LAS unsigned* st) {
    XcdBarrier b; b.bar = bar; b.x = xb_xcc_id(); b.st = st;
    if (threadIdx.x == 0) (void)xb_add(&bar[XB_XCNT(b.x)], 1u);
    return b;
}
__device__ __forceinline__ void xcd_barrier_complete(unsigned* bar, unsigned x, unsigned& nloc, unsigned& nx) {
    const unsigned G = gridDim.x * gridDim.y * gridDim.z;
    unsigned sum, cnt, mine, sp = 0u;
    for (;;) {
        sum = 0u; cnt = 0u; mine = 0u;
#pragma unroll
        for (unsigned j = 0; j < 16; ++j) { const unsigned c = xb_ld(&bar[XB_XCNT(j)]); sum += c; cnt += (c > 0u) ? 1u : 0u; mine = (j == x) ? c : mine; }
        if (sum == G) break;
        __builtin_amdgcn_s_sleep(1);
        if ((++sp & 255u) == 0u) { if (xb_ld(&bar[XB_TMO])) break; if (sp > XB_SPIN_CAP) { atomicAdd(&bar[XB_TMO], 1u); break; } }
    }
    nloc = mine > 0u ? mine : 1u; nx = cnt > 0u ? cnt : 1u;
}
__device__ __forceinline__ void xcd_barrier(const XcdBarrier& b) {
    asm volatile("s_waitcnt vmcnt(0)" ::: "memory");
    __syncthreads();
    if (threadIdx.x == 0) {
        unsigned* bar = b.bar;
        __builtin_amdgcn_s_waitcnt(0);
        unsigned nloc = b.st[0], nx = b.st[1];
        if (nloc == 0u) { xcd_barrier_complete(bar, b.x, nloc, nx); b.st[0] = nloc; b.st[1] = nx; }
        const unsigned old = xb_add(&bar[XB_XSUB(b.x)], 1u);
        const unsigned gen = old / nloc;
        if (old + 1u == (gen + 1u) * nloc) {
            __builtin_amdgcn_fence(__ATOMIC_RELEASE, "agent");
            asm volatile("s_waitcnt vmcnt(0)" ::: "memory");
            const unsigned og = xb_add(&bar[XB_TOP], 1u);
            const unsigned tg = og / nx;
            if (og + 1u == (tg + 1u) * nx) xb_add(&bar[XB_TOPGEN], 1u);
            else XB_SPIN(xb_ld(&bar[XB_TOPGEN]) == tg, bar);
            __builtin_amdgcn_fence(__ATOMIC_ACQUIRE, "agent");
            xb_add(&bar[XB_XGEN(b.x)], 1u);
            asm volatile("s_waitcnt vmcnt(0)" ::: "memory");
        } else {
            XB_SPIN(xb_ld(&bar[XB_XGEN(b.x)]) == gen, bar);
            __builtin_amdgcn_fence(__ATOMIC_ACQUIRE, "agent");
            asm volatile("s_waitcnt vmcnt(0)" ::: "memory");
        }
    }
    __syncthreads();
}

struct Args { const float* in[18]; float* out; unsigned char* ws; };

using pg8::GUnit;

struct EpiQKVG {
    bf16_t* Q; bf16_t* K; bf16_t* V; bf16_t* G; const float* qg; const float* kg; const float* bgate; const LAS float* rope;
    __device__ __forceinline__ void operator()(f32x4 (&acc)[2][2][4][2], const GUnit& u, int wr, int wc, int fr, int fq) const {
        const int row0 = u.pm * 256 + wr * 64 + fr;
        if (u.kind <= 1) {
            const float* gg = u.kind == 0 ? qg : kg;
            f32x4 gn[2][2];
#pragma unroll
            for (int bj = 0; bj < 2; ++bj)
#pragma unroll
                for (int n = 0; n < 2; ++n) gn[bj][n] = *(const f32x4*)(gg + 32 * bj + 16 * n + 4 * fq);
            const float osc = u.kind == 0 ? ATT_C2 : 1.0f;
            bf16_t* base = u.kind == 0 ? Q + (size_t)(u.aux * 4 + wc) * 64 : K + (size_t)wc * 64;
            const size_t pitch = u.kind == 0 ? 1024 : 256;
#pragma unroll
            for (int ai = 0; ai < 2; ++ai)
#pragma unroll
                for (int m = 0; m < 4; ++m) {
                    const int row = row0 + ai * 128 + m * 16; const int t = row & (SEQ - 1); const int pr = t >> 6, pc = t & 63;
                    float ss = 0.f;
#pragma unroll
                    for (int bj = 0; bj < 2; ++bj)
#pragma unroll
                        for (int n = 0; n < 2; ++n) { const f32x4 x = acc[ai][bj][m][n]; ss += (x[0] * x[0] + x[1] * x[1]) + (x[2] * x[2] + x[3] * x[3]); }
                    ss += __shfl_xor(ss, 16); ss += __shfl_xor(ss, 32);
                    const float rstd = 1.0f / sqrtf(ss * (1.0f / 64.0f) + QK_EPS);
                    bf16_t* dst = base + (size_t)row * pitch + 16 * fq;
#pragma unroll
                    for (int bj = 0; bj < 2; ++bj) {
                        const int pos = bj ? pc : pr;
                        const f32x4 cs = *(const LAS f32x4*)(rope + pos * 32 + 4 * fq), sn = *(const LAS f32x4*)(rope + pos * 32 + 16 + 4 * fq);
                        const f32x4 x1 = acc[ai][bj][m][0] * rstd * gn[bj][0], x2 = acc[ai][bj][m][1] * rstd * gn[bj][1];
                        const f32x4 o1 = (x1 * cs - x2 * sn) * osc, o2 = (x2 * cs + x1 * sn) * osc;
                        u32x4 w; w.x = cvt_pk_bf16(o1[0], o1[1]); w.y = cvt_pk_bf16(o1[2], o1[3]); w.z = cvt_pk_bf16(o2[0], o2[1]); w.w = cvt_pk_bf16(o2[2], o2[3]);
                        *(u32x4*)(dst + 8 * bj) = w; }
                }
        } else {
            const bool isg = u.kind == 3;
            bf16_t* base = isg ? G + (size_t)u.aux * 256 : V; const size_t pitch = isg ? 2048 : 256;
            const int col0 = wc * 32 + 8 * fq;
            f32x4 bv[2][2];
#pragma unroll
            for (int bj = 0; bj < 2; ++bj)
#pragma unroll
                for (int n = 0; n < 2; ++n) bv[bj][n] = isg ? *(const f32x4*)(bgate + u.aux * 256 + col0 + bj * 128 + 4 * n) : (f32x4){0.f, 0.f, 0.f, 0.f};
#pragma unroll
            for (int ai = 0; ai < 2; ++ai)
#pragma unroll
                for (int m = 0; m < 4; ++m) { bf16_t* rowp = base + (size_t)(row0 + ai * 128 + m * 16) * pitch + col0;
#pragma unroll
                    for (int bj = 0; bj < 2; ++bj) { f32x4 v0 = acc[ai][bj][m][0] + bv[bj][0], v1 = acc[ai][bj][m][1] + bv[bj][1];
                        if (isg) {
#pragma unroll
                            for (int j = 0; j < 4; ++j) { v0[j] = fast_sigmoid(v0[j]); v1[j] = fast_sigmoid(v1[j]); } }
                        u32x4 w; w.x = cvt_pk_bf16(v0[0], v0[1]); w.y = cvt_pk_bf16(v0[2], v0[3]); w.z = cvt_pk_bf16(v1[0], v1[1]); w.w = cvt_pk_bf16(v1[2], v1[3]);
                        *(u32x4*)(rowp + bj * 128) = w; } }
        }
    }
};
struct EpiUT {
    bf16_t* UT;
    __device__ __forceinline__ void operator()(f32x4 (&acc)[2][2][4][2], const GUnit& u, int wr, int wc, int fr, int fq) const {
        const int b = u.pn >> 3; const int cs = u.pm >> 1;
        const int nbase = (u.pn & 7) * 256 + wc * 32 + 8 * fq;
#pragma unroll
        for (int ai = 0; ai < 2; ++ai)
#pragma unroll
            for (int m = 0; m < 4; ++m) { const int r = (u.pm & 1) * 256 + ai * 128 + wr * 64 + m * 16 + fr;
                const int ridx = (r & ~31) + pg8::invperm32(r & 31);
                bf16_t* rowp = UT + ((size_t)(b * 512 + ridx) * 4096 + cs * 2048 + nbase);
#pragma unroll
                for (int bj = 0; bj < 2; ++bj) { const f32x4 v0 = acc[ai][bj][m][0], v1 = acc[ai][bj][m][1];
                    u32x4 w; w.x = cvt_pk_bf16(v0[0], v0[1]); w.y = cvt_pk_bf16(v0[2], v0[3]); w.z = cvt_pk_bf16(v1[0], v1[1]); w.w = cvt_pk_bf16(v1[2], v1[3]);
                    *(u32x4*)(rowp + bj * 128) = w; } }
    }
};
struct EpiBf16P {
    int pitch;
    __device__ __forceinline__ void operator()(f32x4 (&acc)[2][2][4][2], const GUnit& u, int wr, int wc, int fr, int fq) const {
        bf16_t* base = (bf16_t*)u.out + (size_t)(wr * 64 + fr) * pitch + u.pn * 256 + wc * 32 + 8 * fq;
#pragma unroll
        for (int ai = 0; ai < 2; ++ai)
#pragma unroll
            for (int m = 0; m < 4; ++m) { bf16_t* rowp = base + (size_t)(ai * 128 + m * 16) * pitch;
#pragma unroll
                for (int bj = 0; bj < 2; ++bj) { const f32x4 v0 = acc[ai][bj][m][0], v1 = acc[ai][bj][m][1];
                    u32x4 w; w.x = cvt_pk_bf16(v0[0], v0[1]); w.y = cvt_pk_bf16(v0[2], v0[3]); w.z = cvt_pk_bf16(v1[0], v1[1]); w.w = cvt_pk_bf16(v1[2], v1[3]);
                    *(u32x4*)(rowp + bj * 128) = w; } }
    }
};
struct EpiMerged {
    const bf16_t* __restrict__ G; bf16_t* __restrict__ MG;
    __device__ __forceinline__ void operator()(f32x4 (&acc)[2][2][4][2], const GUnit& u, int wr, int wc, int fr, int fq) const {
        const int row0 = u.pm * 256 + wr * 64 + fr, col0 = u.pn * 256 + wc * 32 + 8 * fq;
#pragma unroll
        for (int ai = 0; ai < 2; ++ai) {
            u32x4 g2w[4][2], g1w[4][2];
#pragma unroll
            for (int m = 0; m < 4; ++m)
#pragma unroll
                for (int bj = 0; bj < 2; ++bj) { const size_t row = (size_t)(row0 + ai * 128 + m * 16);
                    g2w[m][bj] = *(const u32x4*)(G + row * 2048 + 1024 + col0 + bj * 128);
                    if (u.kind == 0) g1w[m][bj] = *(const u32x4*)(G + row * 2048 + col0 + bj * 128); else g1w[m][bj] = (u32x4){0u, 0u, 0u, 0u}; }
#pragma unroll
            for (int m = 0; m < 4; ++m)
#pragma unroll
                for (int bj = 0; bj < 2; ++bj) { const size_t row = (size_t)(row0 + ai * 128 + m * 16);
                    const u32x4 a = g2w[m][bj];
                    float g2[8] = {bf_lo(a.x), bf_hi(a.x), bf_lo(a.y), bf_hi(a.y), bf_lo(a.z), bf_hi(a.z), bf_lo(a.w), bf_hi(a.w)};
#pragma unroll
                    for (int j = 0; j < 8; ++j) g2[j] = fmaxf(g2[j], 1e-30f);
                    if (u.kind == 0) {
                        const u32x4 b = g1w[m][bj];
                        const float g1[8] = {bf_lo(b.x), bf_hi(b.x), bf_lo(b.y), bf_hi(b.y), bf_lo(b.z), bf_hi(b.z), bf_lo(b.w), bf_hi(b.w)};
#pragma unroll
                        for (int j = 0; j < 4; ++j) { acc[ai][bj][m][0][j] *= g1[j] * __builtin_amdgcn_rcpf(g2[j]); acc[ai][bj][m][1][j] *= g1[4 + j] * __builtin_amdgcn_rcpf(g2[4 + j]); }
                    } else {
                        f32x4 v0, v1;
#pragma unroll
                        for (int j = 0; j < 4; ++j) { v0[j] = acc[ai][bj][m][0][j] * g2[j]; v1[j] = acc[ai][bj][m][1][j] * g2[4 + j]; }
                        u32x4 w; w.x = cvt_pk_bf16(v0[0], v0[1]); w.y = cvt_pk_bf16(v0[2], v0[3]); w.z = cvt_pk_bf16(v1[0], v1[1]); w.w = cvt_pk_bf16(v1[2], v1[3]);
                        *(u32x4*)(MG + row * 1024 + col0 + bj * 128) = w; } } }
    }
};
struct EpiF32 {
    float* __restrict__ C; int ldc; const float* __restrict__ R; float rs;
    __device__ __forceinline__ void operator()(f32x4 (&acc)[2][2][4][2], const GUnit& u, int wr, int wc, int fr, int fq) const {
        const int row0 = u.pm * 256 + wr * 64 + fr, col0 = u.pn * 256 + wc * 32 + 4 * fq;
#pragma unroll
        for (int ai = 0; ai < 2; ++ai)
#pragma unroll
            for (int mp = 0; mp < 2; ++mp) {
                f32x4 rv[2][2][2];
                if (R) {
#pragma unroll
                    for (int mm = 0; mm < 2; ++mm)
#pragma unroll
                        for (int bj = 0; bj < 2; ++bj)
#pragma unroll
                            for (int n = 0; n < 2; ++n) rv[mm][bj][n] = *(const f32x4*)(R + (size_t)(row0 + ai * 128 + (mp * 2 + mm) * 16) * ldc + col0 + bj * 128 + n * 16);
                }
#pragma unroll
                for (int mm = 0; mm < 2; ++mm) { const int m = mp * 2 + mm; const size_t off = (size_t)(row0 + ai * 128 + m * 16) * ldc + col0;
#pragma unroll
                    for (int bj = 0; bj < 2; ++bj)
#pragma unroll
                        for (int n = 0; n < 2; ++n) { f32x4 v = acc[ai][bj][m][n]; if (R) v += rv[mm][bj][n] * rs; *(f32x4*)(C + off + bj * 128 + n * 16) = v; } }
                asm volatile("" ::: "memory"); }
    }
};
struct EpiSwiglu {
    __device__ __forceinline__ void operator()(f32x4 (&acc)[2][2][4][2], const GUnit& u, int wr, int wc, int fr, int fq) const {
        bf16_t* base = (bf16_t*)u.out + (size_t)(wr * 64 + fr) * 256 + u.pn * 128 + wc * 32 + 8 * fq;
#pragma unroll
        for (int ai = 0; ai < 2; ++ai)
#pragma unroll
            for (int m = 0; m < 4; ++m) { f32x4 h[2];
#pragma unroll
                for (int n = 0; n < 2; ++n)
#pragma unroll
                    for (int j = 0; j < 4; ++j) { const float g = acc[ai][0][m][n][j]; h[n][j] = g * fast_sigmoid(g) * acc[ai][1][m][n][j]; }
                u32x4 w; w.x = cvt_pk_bf16(h[0][0], h[0][1]); w.y = cvt_pk_bf16(h[0][2], h[0][3]); w.z = cvt_pk_bf16(h[1][0], h[1][1]); w.w = cvt_pk_bf16(h[1][2], h[1][3]);
                *(u32x4*)(base + (size_t)(ai * 128 + m * 16) * 256) = w; }
    }
};
struct EpiY {
    const int* __restrict__ row_slot; const float* __restrict__ row_w;
    __device__ __forceinline__ void operator()(f32x4 (&acc)[2][2][4][2], const GUnit& u, int wr, int wc, int fr, int fq) const {
        const int col0 = u.pn * 256 + wc * 32 + 8 * fq;
        int slot[2][4]; float wv[2][4];
#pragma unroll
        for (int ai = 0; ai < 2; ++ai)
#pragma unroll
            for (int m = 0; m < 4; ++m) { const int r = u.aux * 256 + ai * 128 + wr * 64 + m * 16 + fr;
                if (u.kind == 0) { slot[ai][m] = row_slot[r]; wv[ai][m] = row_w[r]; } else { slot[ai][m] = r; wv[ai][m] = 1.0f; } }
#pragma unroll
        for (int ai = 0; ai < 2; ++ai)
#pragma unroll
            for (int m = 0; m < 4; ++m) {
                if (slot[ai][m] >= 0) { bf16_t* rowp = (bf16_t*)u.out + (size_t)slot[ai][m] * 1024 + col0; const float w = wv[ai][m];
#pragma unroll
                    for (int bj = 0; bj < 2; ++bj) { const f32x4 v0 = acc[ai][bj][m][0] * w, v1 = acc[ai][bj][m][1] * w;
                        u32x4 o; o.x = cvt_pk_bf16(v0[0], v0[1]); o.y = cvt_pk_bf16(v0[2], v0[3]); o.z = cvt_pk_bf16(v1[0], v1[1]); o.w = cvt_pk_bf16(v1[2], v1[3]);
                        *(u32x4*)(rowp + bj * 128) = o; } } }
    }
};

struct SchedBase { int G, c; };
struct SchedP1a : SchedBase { static constexpr bool GATHER = false; const char* xb; const char* W;
    __device__ __forceinline__ bool next(int i, GUnit& u) const { const int L = i * G + c; if (L >= 128 * 14) return false; int pm, pn; pg8::tile_order(L, 128, 14, pm, pn);
        u.A = xb + (size_t)pm * 256 * 2048; u.B = W + (size_t)pn * 256 * 2048; u.out = nullptr; u.gather = nullptr; u.lda = 2048; u.ldb = 2048; u.K = 1024; u.pm = pm; u.pn = pn; u.flags = 0;
        if (pn < 4) { u.kind = 0; u.aux = pn; } else if (pn == 4) { u.kind = 1; u.aux = 0; } else if (pn == 5) { u.kind = 2; u.aux = 0; } else { u.kind = 3; u.aux = pn - 6; }
        return true; } };
struct SchedP1b : SchedBase { static constexpr bool GATHER = false; const char* xb; const char* W;
    __device__ __forceinline__ bool next(int i, GUnit& u) const { const int L = i * G + c; if (L >= 512) return false; const int pn = L >> 2, pm = L & 3;
        u.A = W + (size_t)pm * 256 * 2048; u.B = xb + (size_t)pn * 256 * 2048; u.out = nullptr; u.gather = nullptr; u.lda = 2048; u.ldb = 2048; u.K = 1024; u.pm = pm; u.pn = pn; u.kind = 0; u.aux = 0; u.flags = 2; return true; } };
struct SchedF : SchedBase { static constexpr bool GATHER = false; const char* dft; const char* UT; char* F;
    __device__ __forceinline__ bool next(int i, GUnit& u) const { const int L = i * G + c; if (L >= 256) return false; const int b = L >> 4, pm = (L >> 1) & 7, pn = L & 1;
        u.A = dft + (size_t)pm * 256 * 8192; u.B = UT + ((size_t)b * 512 + pn * 256) * 8192; u.out = F + ((size_t)b * 2048 + pm * 256) * 1024; u.gather = nullptr; u.lda = 8192; u.ldb = 8192; u.K = 4096;
        u.pm = pm; u.pn = pn; u.kind = 0; u.aux = b; u.flags = 0; return true; } };
struct SchedMerged : SchedBase { static constexpr bool GATHER = false; const char* F; const char* AO; const char* Wf; const char* Wa;
    __device__ __forceinline__ bool next(int i, GUnit& u) const { const int L = (i >> 1) * G + c; if (L >= 512) return false; int pm, pn; pg8::tile_order(L, 128, 4, pm, pn); const int seg = i & 1;
        u.out = nullptr; u.gather = nullptr; u.pm = pm; u.pn = pn; u.kind = seg; u.aux = 0; u.flags = seg;
        if (seg == 0) { u.A = F + (size_t)pm * 256 * 1024; u.B = Wf + (size_t)pn * 256 * 1024; u.lda = 1024; u.ldb = 1024; u.K = 512; }
        else { u.A = AO + (size_t)pm * 256 * 2048; u.B = Wa + (size_t)pn * 256 * 2048; u.lda = 2048; u.ldb = 2048; u.K = 1024; }
        return true; } };
struct SchedPlain : SchedBase { static constexpr bool GATHER = false; const char* A; const char* B; int nM, nN;
    __device__ __forceinline__ bool next(int i, GUnit& u) const { const int L = i * G + c; if (L >= nM * nN) return false; int pm, pn; pg8::tile_order(L, nM, nN, pm, pn);
        u.A = A + (size_t)pm * 256 * 2048; u.B = B + (size_t)pn * 256 * 2048; u.out = nullptr; u.gather = nullptr; u.lda = 2048; u.ldb = 2048; u.K = 1024; u.pm = pm; u.pn = pn; u.kind = 0; u.aux = 0; u.flags = 0; return true; } };
struct SchedUp : SchedBase { static constexpr bool GATHER = true; const char* x1b; const char* Wein; const char* Wshin; char* H; char* Hs; const int* row_tok; const int* iota; const LAS int* tile_e; int ntiles;
    __device__ __forceinline__ bool next(int i, GUnit& u) const { const int tot = 2 * ntiles + 256; const int L0 = i * G + c; if (L0 >= tot) return false; const int L = pg8::xcd_remap(L0, tot);
        u.A = x1b; u.lda = 2048; u.ldb = 2048; u.K = 1024; u.kind = 0; u.flags = 0; u.pm = 0;
        if (L < 2 * ntiles) { const int j = L >> 1, pn = L & 1; const int e = __builtin_amdgcn_readfirstlane(tile_e[j]);
            u.gather = row_tok + (size_t)j * 256; u.B = Wein + ((size_t)e * 512 + pn * 256) * 2048; u.out = H + (size_t)j * 256 * 512; u.pn = pn; u.aux = j; }
        else { const int s = (L - 2 * ntiles) >> 1, pn = L & 1;
            u.gather = iota + (size_t)s * 256; u.B = Wshin + (size_t)pn * 256 * 2048; u.out = Hs + (size_t)s * 256 * 512; u.pn = pn; u.aux = s; }
        return true; } };
struct SchedDown : SchedBase { static constexpr bool GATHER = false; const char* H; const char* Hs; const char* Wed; const char* Wshd; char* Y; char* Ysh; const LAS int* tile_e; int ntiles;
    __device__ __forceinline__ bool next(int i, GUnit& u) const { const int tot = 4 * ntiles + 512; const int L0 = i * G + c; if (L0 >= tot) return false; const int L = pg8::xcd_remap(L0, tot);
        u.gather = nullptr; u.lda = 512; u.ldb = 512; u.K = 256; u.flags = 0; u.pm = 0;
        if (L < 4 * ntiles) { const int j = L >> 2, pn = L & 3; const int e = __builtin_amdgcn_readfirstlane(tile_e[j]);
            u.A = H + (size_t)j * 256 * 512; u.B = Wed + ((size_t)e * 1024 + pn * 256) * 512; u.pn = pn; u.aux = j; u.kind = 0; u.out = Y; }
        else { const int s = (L - 4 * ntiles) >> 2, pn = L & 3;
            u.A = Hs + (size_t)s * 256 * 512; u.B = Wshd + (size_t)pn * 256 * 512; u.pn = pn; u.aux = s; u.kind = 1; u.out = Ysh; }
        return true; } };

__device__ __forceinline__ float wave_sum(float v) {
#pragma unroll
    for (int o = 1; o < 64; o <<= 1) v += __shfl_xor(v, o);
    return v;
}
__device__ __forceinline__ void transpose_tile(const float* __restrict__ W, size_t ldw, bf16_t* __restrict__ WT, size_t ldt, int k0, int n0, int drow0, int drow1, bool perm, LAS float* scr, int lane) {
    const int kk = lane >> 4, n4 = (lane & 15) * 4;
    f32x4 v[16];
#pragma unroll
    for (int i = 0; i < 16; ++i) v[i] = *(const f32x4*)(W + (size_t)(k0 + 4 * i + kk) * ldw + n0 + n4);
#pragma unroll
    for (int i = 0; i < 16; ++i) { const int k = 4 * i + kk; scr[(n4 + 0) * 65 + k] = v[i][0]; scr[(n4 + 1) * 65 + k] = v[i][1]; scr[(n4 + 2) * 65 + k] = v[i][2]; scr[(n4 + 3) * 65 + k] = v[i][3]; }
    LDS_WAIT(); asm volatile("" ::: "memory");
    const int c = lane & 7;
#pragma unroll
    for (int p = 0; p < 8; ++p) { const int n = p * 8 + (lane >> 3); const LAS float* s = scr + n * 65 + 8 * c;
        u32x4 o; o.x = cvt_pk_bf16(s[0], s[1]); o.y = cvt_pk_bf16(s[2], s[3]); o.z = cvt_pk_bf16(s[4], s[5]); o.w = cvt_pk_bf16(s[6], s[7]);
        const int sidx = n & 31; const int row = ((n >> 5) ? drow1 : drow0) + (perm ? pg8::invperm32(sidx) : sidx);
        *(u32x4*)(WT + (size_t)row * ldt + k0 + 8 * c) = o; }
    LDS_WAIT(); asm volatile("" ::: "memory");
}
__device__ __forceinline__ int qkvg_row(int n, bool& perm) {
    if (n < OFFK) { const int nn = n - OFFQ, head = nn >> 6, half = (nn >> 5) & 1; perm = false; return (head >> 2) * 256 + 128 * half + 32 * (head & 3); }
    if (n < OFFV) { const int nn = n - OFFK, head = nn >> 6, half = (nn >> 5) & 1; perm = false; return 1024 + 128 * half + 32 * head; }
    perm = true; return 1280 + (n - OFFV);
}
__device__ __forceinline__ int swiglu_row(int n) { const int part = n >> 8, hc = n & 255; return (hc >> 7) * 256 + 128 * part + (hc & 127); }

__global__ void __launch_bounds__(512, 2) mega_fwd(Args args) {
    extern __shared__ __attribute__((aligned(16))) unsigned char lds_raw[];
    LAS unsigned char* lds = (LAS unsigned char*)lds_raw;
    volatile LAS unsigned* MISC = (volatile LAS unsigned*)(lds + MISC_OFF);
    const int G = gridDim.x; const int bx = blockIdx.x; const int vcu = (G % 8 == 0) ? (bx % 8) * (G / 8) + bx / 8 : bx;
    unsigned char* ws = args.ws;
    unsigned* ctl = (unsigned*)(ws + WS_CTL);
    const float* x = args.in[0]; const float* w_in = args.in[1]; const float* b_gate = args.in[2]; const float* q_norm_g = args.in[3]; const float* k_norm_g = args.in[4];
    const float* w_four = args.in[5]; const float* w_attn = args.in[6]; const float* w_o = args.in[7]; const float* ln1_g = args.in[8]; const float* ln1_b = args.in[9];
    const float* w_router = args.in[10]; const float* e_bias = args.in[11]; const float* w_e_in = args.in[12]; const float* w_e_down = args.in[13];
    const float* w_sh_in = args.in[14]; const float* w_sh_down = args.in[15]; const float* ln2_g = args.in[16]; const float* ln2_b = args.in[17];
    float* out = args.out;
    bf16_t* WqkvgT = (bf16_t*)(ws + WS_WQKVG); bf16_t* WcsT = (bf16_t*)(ws + WS_WCS); bf16_t* WfT = (bf16_t*)(ws + WS_WF); bf16_t* WaT = (bf16_t*)(ws + WS_WA); bf16_t* WoT = (bf16_t*)(ws + WS_WO);
    bf16_t* WrT = (bf16_t*)(ws + WS_WR); bf16_t* WshinT = (bf16_t*)(ws + WS_WSHIN); bf16_t* WshdT = (bf16_t*)(ws + WS_WSHD); bf16_t* DFT = (bf16_t*)(ws + WS_DFT);
    bf16_t* WeinT = (bf16_t*)(ws + WS_WEIN); bf16_t* WedT = (bf16_t*)(ws + WS_WED);
    int* iota = (int*)(ws + WS_IOTA); int* asg_e = (int*)(ws + WS_ASG_E); int* asg_pos = (int*)(ws + WS_ASG_POS); float* asg_w = (float*)(ws + WS_ASG_W);
    int* row_tok = (int*)(ws + WS_ROW_TOK); int* row_slot = (int*)(ws + WS_ROW_SLOT); float* row_w = (float*)(ws + WS_ROW_W);
    float* X1 = (float*)(ws + WS_X1); bf16_t* X1B = (bf16_t*)(ws + WS_X1B); float* PRE = (float*)(ws + WS_PRE); float* LOGITS = (float*)(ws + WS_LOGITS);
    bf16_t* Hb = (bf16_t*)(ws + WS_H); bf16_t* Hsb = (bf16_t*)(ws + WS_HS); bf16_t* YSH = (bf16_t*)(ws + WS_YSH); bf16_t* YBUF = (bf16_t*)(ws + WS_YBUF);
    bf16_t* XB = (bf16_t*)(ws + WS_XB); bf16_t* UT = (bf16_t*)(ws + WS_UT); bf16_t* Qb = (bf16_t*)(ws + WS_Q); bf16_t* Kb = (bf16_t*)(ws + WS_K); bf16_t* Vb = (bf16_t*)(ws + WS_V);
    bf16_t* Gb = (bf16_t*)(ws + WS_G); bf16_t* Fb = (bf16_t*)(ws + WS_F); bf16_t* AO = (bf16_t*)(ws + WS_AO); bf16_t* MG = (bf16_t*)(ws + WS_MERGED);
    unsigned* ecnt = ctl + CW_CNT;

    if (threadIdx.x < 32) MISC[threadIdx.x] = 0u;
    __syncthreads();
    XcdBarrier bar = xcd_barrier_post(ctl + CW_BAR, MISC + 8);
#define GRID_BAR() xcd_barrier(bar)
#define PHASE_IDS() int tid_ = threadIdx.x; asm volatile("" : "+v"(tid_)); const int tid = tid_, lane = tid & 63, wave = __builtin_amdgcn_readfirstlane(tid >> 6); \
    const int gw = vcu * 8 + wave, NGW = G * 8; const size_t gt = (size_t)vcu * 512 + tid, NGT = (size_t)G * 512; (void)lane; (void)gw; (void)NGW; (void)gt; (void)NGT

    {
        PHASE_IDS();
        LAS float* scr = (LAS float*)(lds + wave * 16640);
        constexpr int I_EIN = NEXP * 16 * 8, I_ED = NEXP * 4 * 16, I_QKVG = 16 * 56, I_F = 8 * 16, I_A = 16 * 16, I_O = 16 * 16, I_R = 16 * 4, I_SHIN = 16 * 8, I_SHD = 4 * 16;
        constexpr int NITEMS = I_EIN + I_ED + I_QKVG + I_F + I_A + I_O + I_R + I_SHIN + I_SHD;
        for (int it = gw; it < NITEMS; it += NGW) {
            int r = it;
            if (r < I_EIN) { const int e = r >> 7, q = r & 127, kb = q >> 3, nb = q & 7; const int d0 = swiglu_row(nb * 64);
                transpose_tile(w_e_in + (size_t)e * 1024 * 512, 512, WeinT + (size_t)e * 512 * 1024, 1024, kb * 64, nb * 64, d0, d0 + 32, true, scr, lane); continue; } r -= I_EIN;
            if (r < I_ED) { const int e = r >> 6, q = r & 63, kb = q >> 4, nb = q & 15;
                transpose_tile(w_e_down + (size_t)e * 256 * 1024, 1024, WedT + (size_t)e * 1024 * 256, 256, kb * 64, nb * 64, nb * 64, nb * 64 + 32, true, scr, lane); continue; } r -= I_ED;
            if (r < I_QKVG) { const int kb = r / 56, nb = r % 56; const int n0 = OFFQ + nb * 64; bool p0, p1; const int d0 = qkvg_row(n0, p0), d1 = qkvg_row(n0 + 32, p1);
                transpose_tile(w_in, INW, WqkvgT, 1024, kb * 64, n0, d0, d1, p0, scr, lane); continue; } r -= I_QKVG;
            if (r < I_F) { const int kb = r >> 4, nb = r & 15; transpose_tile(w_four, 1024, WfT, 512, kb * 64, nb * 64, nb * 64, nb * 64 + 32, true, scr, lane); continue; } r -= I_F;
            if (r < I_A) { const int kb = r >> 4, nb = r & 15; transpose_tile(w_attn, 1024, WaT, 1024, kb * 64, nb * 64, nb * 64, nb * 64 + 32, true, scr, lane); continue; } r -= I_A;
            if (r < I_O) { const int kb = r >> 4, nb = r & 15; transpose_tile(w_o, 1024, WoT, 1024, kb * 64, nb * 64, nb * 64, nb * 64 + 32, false, scr, lane); continue; } r -= I_O;
            if (r < I_R) { const int kb = r >> 2, nb = r & 3; transpose_tile(w_router, 256, WrT, 1024, kb * 64, nb * 64, nb * 64, nb * 64 + 32, false, scr, lane); continue; } r -= I_R;
            if (r < I_SHIN) { const int kb = r >> 3, nb = r & 7; const int d0 = swiglu_row(nb * 64); transpose_tile(w_sh_in, 512, WshinT, 1024, kb * 64, nb * 64, d0, d0 + 32, true, scr, lane); continue; } r -= I_SHIN;
            { const int kb = r >> 4, nb = r & 15; transpose_tile(w_sh_down, 1024, WshdT, 256, kb * 64, nb * 64, nb * 64, nb * 64 + 32, true, scr, lane); }
        }
        {
            const float scale = 1.0f / sqrtf((float)SEQ * 64.0f);
            LAS float* tw = scr + 1024;
            { float sn, cs; sincospif((float)lane * (1.0f / 32.0f), &sn, &cs); tw[lane] = cs * scale; tw[64 + lane] = sn * scale; }
            LDS_WAIT(); asm volatile("" ::: "memory");
            for (int it = gw; it < 1024; it += NGW) { const int kb = it >> 4, g = (it >> 1) & 7, cs = it & 1; const int k0 = kb * 16;
#pragma unroll
                for (int kk = 0; kk < 16; ++kk) scr[kk * 64 + lane] = w_in[(size_t)(k0 + kk) * INW + g * 64 + lane];
                LDS_WAIT(); asm volatile("" ::: "memory");
                float o[16];
#pragma unroll
                for (int kk = 0; kk < 16; ++kk) o[kk] = 0.f;
                for (int c = 0; c < 64; ++c) { const float t = tw[cs * 64 + ((c * lane) & 63)];
#pragma unroll
                    for (int kk = 0; kk < 16; ++kk) o[kk] += scr[kk * 64 + c] * t; }
                u32x4 w0, w1; w0.x = cvt_pk_bf16(o[0], o[1]); w0.y = cvt_pk_bf16(o[2], o[3]); w0.z = cvt_pk_bf16(o[4], o[5]); w0.w = cvt_pk_bf16(o[6], o[7]);
                w1.x = cvt_pk_bf16(o[8], o[9]); w1.y = cvt_pk_bf16(o[10], o[11]); w1.z = cvt_pk_bf16(o[12], o[13]); w1.w = cvt_pk_bf16(o[14], o[15]);
                bf16_t* dst = WcsT + (size_t)(cs * 512 + g * 64 + lane) * 1024 + k0;
                *(u32x4*)dst = w0; *(u32x4*)(dst + 8) = w1;
                LDS_WAIT(); asm volatile("" ::: "memory"); }
        }
        __syncthreads();
        {
            LAS float* ct = (LAS float*)(lds + 133120);
            for (int m = tid; m < SEQ; m += 512) ct[m] = cospif((float)m * (1.0f / 1024.0f));
            __syncthreads();
            for (size_t it = gt; it < (size_t)SEQ * 512; it += NGT) { const int k = (int)(it >> 9), j0 = (int)(it & 511) * 8;
                float v[8];
#pragma unroll
                for (int e = 0; e < 8; ++e) { const int j = j0 + e; if (j < SEQ) v[e] = ct[(k * j) & (SEQ - 1)]; else v[e] = -ct[((k * (j - SEQ)) - 512) & (SEQ - 1)]; }
                u32x4 w; w.x = cvt_pk_bf16(v[0], v[1]); w.y = cvt_pk_bf16(v[2], v[3]); w.z = cvt_pk_bf16(v[4], v[5]); w.w = cvt_pk_bf16(v[6], v[7]);
                *(u32x4*)(DFT + (size_t)k * 4096 + j0) = w; }
        }
        for (size_t it = gt; it < (size_t)NTOK * DM / 8; it += NGT) { const f32x4 a = *(const f32x4*)(x + it * 8), b = *(const f32x4*)(x + it * 8 + 4);
            u32x4 w; w.x = cvt_pk_bf16(a[0], a[1]); w.y = cvt_pk_bf16(a[2], a[3]); w.z = cvt_pk_bf16(b[0], b[1]); w.w = cvt_pk_bf16(b[2], b[3]);
            *(u32x4*)(XB + it * 8) = w; }
        for (size_t it = gt; it < (size_t)PMAX; it += NGT) { row_tok[it] = 0; row_slot[it] = -1; row_w[it] = 0.f; }
        for (size_t it = gt; it < (size_t)NTOK; it += NGT) iota[it] = (int)it;
        __syncthreads();
        { LAS float* rope = (LAS float*)(lds + ROPE_OFF);
            for (int q = tid; q < 64 * 16; q += 512) { const int pos = q >> 4, i = q & 15; const float f = powf(10000.0f, -(float)i * (1.0f / 16.0f)); float sn, cs; sincosf((float)pos * f, &sn, &cs);
                rope[pos * 32 + i] = cs; rope[pos * 32 + 16 + i] = sn; } }
        __syncthreads();
    }
    GRID_BAR();

    {
        SchedP1a S; S.G = G; S.c = bx; S.xb = (const char*)XB; S.W = (const char*)WqkvgT;
        EpiQKVG E{Qb, Kb, Vb, Gb, q_norm_g, k_norm_g, b_gate, (const LAS float*)(lds + ROPE_OFF)};
        pg8::gemm_phase<EpiQKVG, SchedP1a>(lds + RING_OFF, S, E);
    }
    {
        SchedP1b S; S.G = G; S.c = bx; S.xb = (const char*)XB; S.W = (const char*)WcsT;
        EpiUT E{UT};
        pg8::gemm_phase<EpiUT, SchedP1b>(lds + RING_OFF, S, E);
    }
    GRID_BAR();

    {
        SchedF S; S.G = G; S.c = vcu; S.dft = (const char*)DFT; S.UT = (const char*)UT; S.F = (char*)Fb;
        EpiBf16P E{512};
        pg8::gemm_phase<EpiBf16P, SchedF>(lds + RING_OFF, S, E);
    }
    {
        for (int i = 0;; ++i) { const int U = i * G + vcu; if (U >= NBATCH * 16 * 8) break;
            const int grp = U >> 5, within = U & 31; const int b = grp >> 2, kvh = grp & 3, hq = within >> 3, qb = within & 7;
            attn_body::attn_unit<8>(b, kvh * 4 + hq, qb, (const attn_body::bf16*)Qb, (const attn_body::bf16*)Kb, (const attn_body::bf16*)Vb, (attn_body::bf16*)AO, (char*)lds_raw + RING_OFF); }
    }
    GRID_BAR();

    {
        SchedMerged S; S.G = G; S.c = bx; S.F = (const char*)Fb; S.AO = (const char*)AO; S.Wf = (const char*)WfT; S.Wa = (const char*)WaT;
        EpiMerged E{Gb, MG};
        pg8::gemm_phase<EpiMerged, SchedMerged>(lds + RING_OFF, S, E);
    }
    GRID_BAR();

    {
        SchedPlain S; S.G = G; S.c = bx; S.A = (const char*)MG; S.B = (const char*)WoT; S.nM = 128; S.nN = 4;
        EpiF32 E{PRE, 1024, x, ALPHA};
        pg8::gemm_phase<EpiF32, SchedPlain>(lds + RING_OFF, S, E);
    }
    GRID_BAR();

    { PHASE_IDS();
    for (int m = gw; m < NTOK; m += NGW) {
        const f32x4* pr = (const f32x4*)(PRE + (size_t)m * DM) + lane;
        f32x4 v[4]; float s = 0.f;
#pragma unroll
        for (int j = 0; j < 4; ++j) { v[j] = pr[64 * j]; s += (v[j][0] + v[j][1]) + (v[j][2] + v[j][3]); }
        const float mean = wave_sum(s) * (1.f / DM); float s2 = 0.f;
#pragma unroll
        for (int j = 0; j < 4; ++j) { v[j] = v[j] - mean; s2 += (v[j][0] * v[j][0] + v[j][1] * v[j][1]) + (v[j][2] * v[j][2] + v[j][3] * v[j][3]); }
        const float rstd = 1.f / sqrtf(wave_sum(s2) * (1.f / DM) + LN_EPS);
#pragma unroll
        for (int j = 0; j < 4; ++j) { const f32x4 g = ((const f32x4*)ln1_g)[lane + 64 * j], bb = ((const f32x4*)ln1_b)[lane + 64 * j]; const f32x4 y = v[j] * rstd * g + bb;
            ((f32x4*)(X1 + (size_t)m * DM))[lane + 64 * j] = y;
            u32x2 w; w.x = cvt_pk_bf16(y[0], y[1]); w.y = cvt_pk_bf16(y[2], y[3]); ((u32x2*)(X1B + (size_t)m * DM))[lane + 64 * j] = w; }
    } }
    GRID_BAR();

    {
        SchedPlain S; S.G = G; S.c = bx; S.A = (const char*)X1B; S.B = (const char*)WrT; S.nM = 128; S.nN = 1;
        EpiF32 E{LOGITS, 256, nullptr, 0.f};
        pg8::gemm_phase<EpiF32, SchedPlain>(lds + RING_OFF, S, E);
    }
    GRID_BAR();

    {
        PHASE_IDS();
        LAS unsigned* hist = (LAS unsigned*)(lds + HIST_OFF); LAS unsigned* wgoff = (LAS unsigned*)(lds + WGOFF_OFF); LAS unsigned* asg = (LAS unsigned*)(lds + ASG_OFF);
        for (int ch = bx; ch < NTOK / 128; ch += G) {
            if (tid < 256) hist[tid] = 0u;
            __syncthreads();
            for (int ii = 0; ii < 16; ++ii) {
                const int tl = wave * 16 + ii, t = ch * 128 + tl;
                const f32x4 lg = *(const f32x4*)(LOGITS + (size_t)t * 256 + 4 * lane); const f32x4 eb = *(const f32x4*)(e_bias + 4 * lane);
                float sc[4], bi[4];
#pragma unroll
                for (int j = 0; j < 4; ++j) { sc[j] = 1.0f / (1.0f + expf(-lg[j])); bi[j] = sc[j] + eb[j]; }
                float m1, m2; { const float a = fmaxf(bi[0], bi[1]), b = fminf(bi[0], bi[1]), c = fmaxf(bi[2], bi[3]), d = fminf(bi[2], bi[3]); m1 = fmaxf(a, c); m2 = fmaxf(fminf(a, c), fmaxf(b, d)); }
#pragma unroll
                for (int off = 1; off < 8; off <<= 1) { const float o1 = __shfl_xor(m1, off), o2 = __shfl_xor(m2, off); const float n1 = fmaxf(m1, o1), n2 = fmaxf(fminf(m1, o1), fmaxf(m2, o2)); m1 = n1; m2 = n2; }
                const float gs = m1 + m2; const int myg = lane >> 3; int rank = 0;
#pragma unroll
                for (int g2 = 0; g2 < 8; ++g2) { const float v = __shfl(gs, 8 * g2); rank += (v > gs || (v == gs && g2 < myg)) ? 1 : 0; }
                const bool sel = rank < 4;
                unsigned long long key[4];
#pragma unroll
                for (int j = 0; j < 4; ++j) { unsigned ub = __float_as_uint(bi[j]); ub = (ub & 0x80000000u) ? ~ub : (ub | 0x80000000u); key[j] = sel ? (((unsigned long long)ub << 32) | (unsigned)(255 - (4 * lane + j))) : 0ull; }
                int my_e = 0; float my_s = 0.f;
                for (int k = 0; k < TOPK; ++k) {
                    unsigned long long best = key[0] > key[1] ? key[0] : key[1]; { const unsigned long long b2 = key[2] > key[3] ? key[2] : key[3]; best = best > b2 ? best : b2; }
#pragma unroll
                    for (int off = 1; off < 64; off <<= 1) { const unsigned long long o = __shfl_xor(best, off); best = best > o ? best : o; }
                    const int idx = 255 - (int)(best & 0xffu); const int ol = idx >> 2, oj = idx & 3;
                    const float sv = oj == 0 ? sc[0] : oj == 1 ? sc[1] : oj == 2 ? sc[2] : sc[3];
                    const float val = __shfl(sv, ol);
                    if (lane == ol) { if (oj == 0) key[0] = 0ull; else if (oj == 1) key[1] = 0ull; else if (oj == 2) key[2] = 0ull; else key[3] = 0ull; }
                    if (lane == k) { my_e = idx; my_s = val; }
                }
                float ssum = (lane < TOPK) ? my_s : 0.f;
#pragma unroll
                for (int off = 1; off < 8; off <<= 1) ssum += __shfl_xor(ssum, off);
                if (lane < TOPK) { const unsigned rk = atomicAdd((unsigned*)&hist[my_e], 1u); asg[tl * 8 + lane] = (unsigned)my_e | (rk << 16); asg_w[(size_t)t * 8 + lane] = my_s / ssum * 2.5f; }
            }
            __syncthreads();
            if (tid < 256) wgoff[tid] = __hip_atomic_fetch_add(ecnt + tid, hist[tid], __ATOMIC_RELAXED, __HIP_MEMORY_SCOPE_AGENT);
            __syncthreads();
            for (int q = tid; q < 1024; q += 512) { const unsigned a = asg[q]; const int e = (int)(a & 0xffffu); asg_e[(size_t)ch * 1024 + q] = e; asg_pos[(size_t)ch * 1024 + q] = (int)(wgoff[e] + (a >> 16)); }
            __syncthreads();
        }
    }
    GRID_BAR();

    {
        PHASE_IDS();
        LAS int* tile_e = (LAS int*)(lds + TILE_E_OFF); LAS int* ebase = (LAS int*)(lds + EBASE_OFF);
        if (tid == 0) { int acc = 0; for (int e = 0; e < NEXP; ++e) { ebase[e] = acc; const int c = (int)__hip_atomic_load(ecnt + e, __ATOMIC_RELAXED, __HIP_MEMORY_SCOPE_AGENT); acc += (c + 255) >> 8; } ebase[NEXP] = acc; MISC[0] = (unsigned)acc; }
        __syncthreads();
        if (tid < NEXP) { const int b0 = ebase[tid], b1 = ebase[tid + 1]; for (int j = b0; j < b1 && j < MAXTILES; ++j) tile_e[j] = tid; }
        __syncthreads();
        for (size_t a = gt; a < (size_t)NTOK * TOPK; a += NGT) { const int e = asg_e[a]; const int row = ebase[e] * 256 + asg_pos[a];
            if (row < PMAX) { row_tok[row] = (int)(a >> 3); row_slot[row] = (int)a; row_w[row] = asg_w[a]; } }
    }
    GRID_BAR();
    const int ntiles = min((int)MISC[0], MAXTILES);

    {
        SchedUp S; S.G = G; S.c = bx; S.x1b = (const char*)X1B; S.Wein = (const char*)WeinT; S.Wshin = (const char*)WshinT; S.H = (char*)Hb; S.Hs = (char*)Hsb; S.row_tok = row_tok; S.iota = iota;
        S.tile_e = (const LAS int*)(lds + TILE_E_OFF); S.ntiles = ntiles;
        EpiSwiglu E{};
        pg8::gemm_phase<EpiSwiglu, SchedUp>(lds + RING_OFF, S, E);
    }
    GRID_BAR();

    {
        SchedDown S; S.G = G; S.c = bx; S.H = (const char*)Hb; S.Hs = (const char*)Hsb; S.Wed = (const char*)WedT; S.Wshd = (const char*)WshdT; S.Y = (char*)YBUF; S.Ysh = (char*)YSH; S.tile_e = (const LAS int*)(lds + TILE_E_OFF); S.ntiles = ntiles;
        EpiY E{row_slot, row_w};
        pg8::gemm_phase<EpiY, SchedDown>(lds + RING_OFF, S, E);
    }
    GRID_BAR();

    {
        PHASE_IDS();
        const bool bad = (__hip_atomic_load(ctl + CW_BAR + XB_TMO, __ATOMIC_RELAXED, __HIP_MEMORY_SCOPE_AGENT) != 0u);
        for (int m = gw; m < NTOK; m += NGW) {
            float v[16];
#pragma unroll
            for (int j = 0; j < 2; ++j) { const int c0 = 8 * lane + 512 * j;
                const f32x4 a = *(const f32x4*)(X1 + (size_t)m * DM + c0), b = *(const f32x4*)(X1 + (size_t)m * DM + c0 + 4);
#pragma unroll
                for (int e = 0; e < 4; ++e) { v[8 * j + e] = ALPHA * a[e]; v[8 * j + 4 + e] = ALPHA * b[e]; }
                { const u32x4 w = *(const u32x4*)(YSH + (size_t)m * DM + c0);
                  v[8 * j + 0] += bf_lo(w.x); v[8 * j + 1] += bf_hi(w.x); v[8 * j + 2] += bf_lo(w.y); v[8 * j + 3] += bf_hi(w.y); v[8 * j + 4] += bf_lo(w.z); v[8 * j + 5] += bf_hi(w.z); v[8 * j + 6] += bf_lo(w.w); v[8 * j + 7] += bf_hi(w.w); }
#pragma unroll
                for (int k = 0; k < TOPK; ++k) { const u32x4 w = *(const u32x4*)(YBUF + ((size_t)m * TOPK + k) * DM + c0);
                  v[8 * j + 0] += bf_lo(w.x); v[8 * j + 1] += bf_hi(w.x); v[8 * j + 2] += bf_lo(w.y); v[8 * j + 3] += bf_hi(w.y); v[8 * j + 4] += bf_lo(w.z); v[8 * j + 5] += bf_hi(w.z); v[8 * j + 6] += bf_lo(w.w); v[8 * j + 7] += bf_hi(w.w); } }
            float s = 0.f;
#pragma unroll
            for (int e = 0; e < 16; ++e) s += v[e];
            const float mean = wave_sum(s) * (1.f / DM); float s2 = 0.f;
#pragma unroll
            for (int e = 0; e < 16; ++e) { v[e] -= mean; s2 += v[e] * v[e]; }
            const float rstd = 1.f / sqrtf(wave_sum(s2) * (1.f / DM) + LN_EPS);
#pragma unroll
            for (int j = 0; j < 2; ++j) { const int c0 = 8 * lane + 512 * j;
#pragma unroll
                for (int h = 0; h < 2; ++h) { const f32x4 g = *(const f32x4*)(ln2_g + c0 + 4 * h), bb = *(const f32x4*)(ln2_b + c0 + 4 * h); f32x4 y;
#pragma unroll
                    for (int e = 0; e < 4; ++e) y[e] = bad ? __builtin_nanf("") : v[8 * j + 4 * h + e] * rstd * g[e] + bb[e];
                    *(f32x4*)(out + (size_t)m * DM + c0 + 4 * h) = y; } }
        }
    }
#undef GRID_BAR
}

extern "C" void kernel_launch(void* const* d_in, const int* in_sizes, int n_in, void* d_out, int out_size, void* d_ws, size_t ws_size, hipStream_t stream) {
    static int grid = 0;
    if (grid == 0) {
        if (n_in != 18 || in_sizes[0] != NTOK * DM || out_size != NTOK * DM || ws_size < WS_END) { fprintf(stderr, "kernel_launch: unexpected problem (n_in %d, in0 %d, out %d, ws %zu)\n", n_in, n_in > 0 ? in_sizes[0] : -1, out_size, ws_size); grid = -1; return; }
        int dev = 0, cus = 0;
        if (hipGetDevice(&dev) != hipSuccess || hipDeviceGetAttribute(&cus, hipDeviceAttributeMultiprocessorCount, dev) != hipSuccess) { grid = -1; return; }
        if (hipFuncSetAttribute((const void*)mega_fwd, hipFuncAttributeMaxDynamicSharedMemorySize, LDS_BYTES) != hipSuccess) { fprintf(stderr, "kernel_launch: hipFuncSetAttribute failed\n"); grid = -1; return; }
        int per_cu = 0;
        if (hipOccupancyMaxActiveBlocksPerMultiprocessor(&per_cu, (const void*)mega_fwd, 512, LDS_BYTES) != hipSuccess || per_cu < 1) fprintf(stderr, "kernel_launch: note: occupancy query reports %d\n", per_cu);
        (void)hipGetLastError();
        grid = cus;
    }
    if (grid < 0) return;
    if (hipMemsetAsync((char*)d_ws + WS_CTL, 0, CTL_ZERO_BYTES, stream) != hipSuccess) return;
    Args a{};
    for (int i = 0; i < 18; ++i) a.in[i] = (const float*)d_in[i];
    a.out = (float*)d_out; a.ws = (unsigned char*)d_ws;
    hipLaunchKernelGGL(mega_fwd, dim3(grid), dim3(512), LDS_BYTES, stream, a);
}
```
